# Optimizing an MI355X kernel written in HIP

```python
import jax, jax.numpy as jnp
from jax import lax
import numpy as np

D_MODEL = 1024
BATCH = 16
SEQ = 2048
DEPTH = 1

GRID_W = 64
CTX_LEN = 256
N_HEADS_M = 4
HEAD_DIM_M = 128
W_M = N_HEADS_M * HEAD_DIM_M
N_HEADS_H = 4
HEAD_DIM_H = 128
W_H = N_HEADS_H * HEAD_DIM_H
CONV_K = 3
CHUNK_M = 64
CHUNK_H = 32
N_EXPERTS = 32
TOP_K = 4
D_EXPERT = D_MODEL
SWIGLU_LIMIT = 7.0
SWIGLU_ALPHA = 1.702
MOE_BLOCK = 256
EPS = 1e-6
SPLIT_SIZES = (2 * W_M, W_M, W_M, W_H, W_H, W_H, 2 * W_H, D_MODEL, D_MODEL, 4 * N_HEADS_M)
SPLIT_POINTS = tuple(np.cumsum(SPLIT_SIZES)[:-1].tolist())
N_IN = int(sum(SPLIT_SIZES))

kernel_name = 'hybrid_mlstm_hgrn2_moe_dit'


def rmsnorm(x, w):
    xf = x.astype(jnp.float32)
    y = xf * lax.rsqrt(jnp.mean(xf * xf, axis=-1, keepdims=True) + EPS)
    return (y * w.astype(jnp.float32)).astype(x.dtype)


def head_norm(o, w, dtype):
    B, H, T, d = o.shape
    y = o * lax.rsqrt(jnp.mean(o * o, axis=-1, keepdims=True) + EPS) * w.astype(jnp.float32).reshape(H, 1, d)
    return y.transpose(0, 2, 1, 3).reshape(B, T, H * d).astype(dtype)


def ada_mod(cvec, w, b):
    return jnp.split(jax.nn.silu(cvec) @ w + b, 6, axis=-1)


def modulate(x, shift, scale):
    return x * (1 + scale[:, None, :]) + shift[:, None, :]


def split_heads(a, H):
    B, T, W = a.shape
    return a.reshape(B, T, H, W // H).transpose(0, 2, 1, 3)


def short_conv(a, w, rows, cols):
    B, T, C = a.shape
    y = lax.conv_general_dilated(a.reshape(B, rows, cols, C), w[:, :, None, :].astype(a.dtype), (1, 1), 'SAME',
                                 dimension_numbers=('NHWC', 'HWIO', 'NHWC'), feature_group_count=C)
    return y.reshape(B, T, C)


def to_chunks(a, L):
    B, H, T = a.shape[:3]
    return jnp.moveaxis(a.reshape(B, H, T // L, L, *a.shape[3:]), 2, 0)


def from_chunks(a):
    NC, B, H, L = a.shape[:4]
    return jnp.moveaxis(a, 0, 2).reshape(B, H, NC * L, *a.shape[4:])


def mlstm_scan(q, k, v, ig, lf, state0, with_output):
    L = CHUNK_M
    mask = jnp.tril(jnp.ones((L, L), bool))
    xs = tuple(to_chunks(a, L) for a in (q, k, v, ig, lf))

    def step(carry, inp):
        C, n, m = carry
        qc, kc, vc, ic, fc = inp
        b = jnp.cumsum(fc, axis=-1)
        bL = b[..., -1]
        logw = bL[..., None] - b + ic
        m_new = jnp.maximum(bL + m, jnp.max(logw, axis=-1))
        w = jnp.exp(logw - m_new[..., None])
        decay = jnp.exp(bL + m - m_new)
        C_new = decay[..., None, None] * C + jnp.einsum('bhs,bhsv,bhsd->bhvd', w, vc, kc)
        n_new = decay[..., None] * n + jnp.einsum('bhs,bhsd->bhd', w, kc)
        if not with_output:
            return (C_new, n_new, m_new), None
        logD = jnp.where(mask, b[..., :, None] - b[..., None, :] + ic[..., None, :], -jnp.inf)
        m_inter = b + m[..., None]
        m_t = jnp.maximum(jnp.max(logD, axis=-1), m_inter)
        s = jnp.einsum('bhtd,bhsd->bhts', qc, kc) * jnp.exp(logD - m_t[..., None])
        inter = jnp.exp(m_inter - m_t)
        num = jnp.einsum('bhts,bhsv->bhtv', s, vc) + inter[..., None] * jnp.einsum('bhtd,bhvd->bhtv', qc, C)
        den = jnp.sum(s, axis=-1) + inter * jnp.einsum('bhtd,bhd->bht', qc, n)
        h = num / jnp.maximum(jnp.abs(den), jnp.exp(-m_t))[..., None]
        return (C_new, n_new, m_new), h

    state, h = lax.scan(step, state0, xs)
    return (from_chunks(h) if with_output else None), state


def hgrn_scan(q, k, i, lf, S0, with_output):
    L = CHUNK_H
    mask = jnp.tril(jnp.ones((L, L), bool))
    xs = tuple(to_chunks(a, L) for a in (q, k, i, lf))

    def step(S, inp):
        qc, kc, ic, fc = inp
        A = jnp.cumsum(fc, axis=2)
        AL = A[:, :, -1]
        S_new = jnp.exp(AL)[..., None] * S + jnp.einsum('bhsd,bhsv->bhdv', kc * jnp.exp(AL[:, :, None] - A), ic)
        if not with_output:
            return S_new, None
        diff = jnp.where(mask[:, :, None], A[:, :, :, None, :] - A[:, :, None, :, :], -jnp.inf)
        s = jnp.einsum('bhtsd,bhsd->bhts', qc[:, :, :, None, :] * jnp.exp(diff), kc)
        o = jnp.einsum('bhts,bhsv->bhtv', s, ic) + jnp.einsum('bhtd,bhdv->bhtv', qc * jnp.exp(A), S)
        return S_new, o

    S, o = lax.scan(step, S0, xs)
    return (from_chunks(o) if with_output else None), S


def flip_t(a, d):
    return jnp.flip(a, axis=2) if d else a


def bidir(scan_fn, lat_dirs, ctx_dirs, state0, ctx_out):
    outs_l, outs_c = [], []
    for d in range(2):
        hc, st = scan_fn(*[flip_t(a, d) for a in ctx_dirs[d]], state0, ctx_out)
        hl, _ = scan_fn(*[flip_t(a, d) for a in lat_dirs[d]], st, True)
        outs_l.append(flip_t(hl, d))
        if ctx_out:
            outs_c.append(flip_t(hc, d))
    return outs_l[0] + outs_l[1], (outs_c[0] + outs_c[1] if ctx_out else None)


def mixer_features(h, w_in, b_in, conv_w, lb, rows, cols):
    B, T, _ = h.shape
    f32 = jnp.float32
    p = h @ w_in + b_in
    mqk, mv, mo, hq, hi, hg, hf, ga, gb, mg = jnp.split(p, SPLIT_POINTS, axis=-1)
    mq, mk = jnp.split(jax.nn.silu(short_conv(mqk, conv_w, rows, cols)), 2, axis=-1)
    mq = split_heads(mq, N_HEADS_M).astype(f32) * HEAD_DIM_M ** -0.5
    mk = split_heads(mk, N_HEADS_M).astype(f32)
    mv = split_heads(mv, N_HEADS_M).astype(f32)
    mg = mg.astype(f32).reshape(B, T, 4, N_HEADS_M).transpose(2, 0, 3, 1)
    m_dirs = [(mq, mk, mv, mg[d], jax.nn.log_sigmoid(mg[2 + d])) for d in range(2)]
    hq = split_heads(jax.nn.silu(hq), N_HEADS_H).astype(f32)
    hi = split_heads(hi, N_HEADS_H).astype(f32)
    z = hf.astype(f32).reshape(B, T, 2, W_H)
    h_dirs = []
    for d in range(2):
        lb_d, zd = lb[d], z[:, :, d]
        logf = jnp.logaddexp(jnp.log(lb_d), jnp.log1p(-lb_d) + jax.nn.log_sigmoid(zd))
        kk = (1 - lb_d) * jax.nn.sigmoid(-zd)
        h_dirs.append((hq, split_heads(kk, N_HEADS_H), hi, split_heads(logf, N_HEADS_H)))
    return m_dirs, h_dirs, (mo, hg, ga, gb)


def merge_branches(mo_h, hg_h, gates, m_norm, h_norm, w_pa, w_pb, w_out, dtype):
    mo, hg, ga, gb = gates
    a = head_norm(mo_h, m_norm, dtype) * jax.nn.sigmoid(mo)
    b = head_norm(hg_h, h_norm, dtype) * jax.nn.silu(hg)
    y = jax.nn.sigmoid(ga) * (a @ w_pa) + jax.nn.sigmoid(gb) * (b @ w_pb)
    return y @ w_out


def token_mixer(hl, hc, w_in, b_in, conv_w, lb, m_norm, h_norm, w_pa, w_pb, w_out, ctx_out):
    B, S, _ = hl.shape
    rows = S // GRID_W
    lm, lh, lg = mixer_features(hl, w_in, b_in, conv_w, lb, rows, GRID_W)
    cm, ch, cg = mixer_features(hc, w_in, b_in, conv_w, lb, 1, hc.shape[1])
    f32 = jnp.float32
    m_state0 = (jnp.zeros((B, N_HEADS_M, HEAD_DIM_M, HEAD_DIM_M), f32),
                jnp.zeros((B, N_HEADS_M, HEAD_DIM_M), f32), jnp.zeros((B, N_HEADS_M), f32))
    h_state0 = jnp.zeros((B, N_HEADS_H, HEAD_DIM_H, HEAD_DIM_H), f32)
    ml, mc = bidir(mlstm_scan, lm, cm, m_state0, ctx_out)
    gl, gc = bidir(hgrn_scan, lh, ch, h_state0, ctx_out)
    yl = merge_branches(ml, gl, lg, m_norm, h_norm, w_pa, w_pb, w_out, hl.dtype)
    yc = merge_branches(mc, gc, cg, m_norm, h_norm, w_pa, w_pb, w_out, hc.dtype) if ctx_out else None
    return yl, yc


def moe_ffn(h, w_router, b_router, w_gu, b_gu, w_dn, b_dn):
    B, T, D = h.shape
    f32 = jnp.float32
    xf = h.reshape(B * T, D)
    N = B * T
    logits = xf.astype(f32) @ w_router.astype(f32) + b_router.astype(f32)
    top_v, top_e = lax.top_k(logits, TOP_K)
    wts = jax.nn.softmax(top_v, axis=-1)
    e_flat = top_e.reshape(-1)
    tok_flat = jnp.repeat(jnp.arange(N, dtype=jnp.int32), TOP_K)
    order = jnp.argsort(e_flat)
    se, stok, sw = e_flat[order], tok_flat[order], wts.reshape(-1)[order]
    counts = jnp.bincount(e_flat, length=N_EXPERTS)
    pcounts = (counts + MOE_BLOCK - 1) // MOE_BLOCK * MOE_BLOCK
    start = jnp.cumsum(counts) - counts
    pend = jnp.cumsum(pcounts)
    pstart = pend - pcounts
    dest = pstart[se] + jnp.arange(N * TOP_K) - start[se]
    P = -(-N * TOP_K // MOE_BLOCK) * MOE_BLOCK + N_EXPERTS * MOE_BLOCK
    n_blocks = P // MOE_BLOCK
    ptok = jnp.full((P,), N, jnp.int32).at[dest].set(stok)
    pw = jnp.zeros((P,), f32).at[dest].set(sw)
    block_e = jnp.minimum(jnp.searchsorted(pend, jnp.arange(n_blocks) * MOE_BLOCK, side='right'), N_EXPERTS - 1)
    xb = jnp.concatenate([xf, jnp.zeros((1, D), xf.dtype)])[ptok].reshape(n_blocks, MOE_BLOCK, D)

    def expert_block(args):
        xblk, e = args
        gate, up = jnp.split(xblk @ w_gu[e] + b_gu[e], 2, axis=-1)
        gate = jnp.minimum(gate, SWIGLU_LIMIT)
        up = jnp.clip(up, -SWIGLU_LIMIT, SWIGLU_LIMIT)
        act = (up + 1) * gate * jax.nn.sigmoid(SWIGLU_ALPHA * gate)
        return act @ w_dn[e] + b_dn[e]

    yb = lax.map(expert_block, (xb, block_e)).reshape(P, D)
    y = jax.ops.segment_sum(yb * pw[:, None].astype(yb.dtype), ptok, num_segments=N + 1)[:N]
    return y.reshape(B, T, D)


def setup_inputs(seed: int = 0) -> dict:
    key = jax.random.key(seed)
    ks = jax.random.split(key, 32)
    nrm = jax.random.normal
    D, F, E, H = D_MODEL, D_EXPERT, N_EXPERTS, N_HEADS_M
    i_bias = 0.1 * nrm(ks[10], (DEPTH, 2, H))
    f_bias = 3.0 + 3.0 * jax.random.uniform(ks[11], (DEPTH, 2, H))
    b_in = jnp.concatenate([0.02 * nrm(ks[12], (DEPTH, N_IN - 4 * H)),
                            jnp.concatenate([i_bias, f_bias], axis=1).reshape(DEPTH, 4 * H)], axis=-1)
    return {
        'x': nrm(ks[0], (BATCH, SEQ, D)),
        'c': nrm(ks[1], (BATCH, D)),
        'ctx': nrm(ks[2], (BATCH, CTX_LEN, D)),
        'c_ctx': nrm(ks[3], (D,)),
        'w_ada': 0.5 * D ** -0.5 * nrm(ks[4], (DEPTH, D, 6 * D)),
        'b_ada': 0.02 * nrm(ks[5], (DEPTH, 6 * D)),
        'norm_mix_pre': 1.0 + 0.05 * nrm(ks[6], (DEPTH, D)),
        'norm_mix_post': 1.0 + 0.05 * nrm(ks[7], (DEPTH, D)),
        'norm_ffn_pre': 1.0 + 0.05 * nrm(ks[8], (DEPTH, D)),
        'norm_ffn_post': 1.0 + 0.05 * nrm(ks[9], (DEPTH, D)),
        'w_in': D ** -0.5 * nrm(ks[13], (DEPTH, D, N_IN)),
        'b_in': b_in,
        'conv_w': (CONV_K * CONV_K) ** -0.5 * nrm(ks[14], (DEPTH, CONV_K, CONV_K, 2 * W_M)),
        'lb_raw': 0.1 * nrm(ks[15], (DEPTH + 1, 2, W_H)),
        'm_norm': 1.0 + 0.05 * nrm(ks[16], (DEPTH, W_M)),
        'h_norm': 1.0 + 0.05 * nrm(ks[17], (DEPTH, W_H)),
        'w_pa': W_M ** -0.5 * nrm(ks[18], (DEPTH, W_M, D)),
        'w_pb': W_H ** -0.5 * nrm(ks[19], (DEPTH, W_H, D)),
        'w_out': D ** -0.5 * nrm(ks[20], (DEPTH, D, D)),
        'w_router': D ** -0.5 * nrm(ks[21], (DEPTH, D, E)),
        'b_router': 0.01 * nrm(ks[22], (DEPTH, E)),
        'w_gu': D ** -0.5 * nrm(ks[23], (DEPTH, E, D, 2 * F)),
        'b_gu': 0.02 * nrm(ks[24], (DEPTH, E, 2 * F)),
        'w_dn': F ** -0.5 * nrm(ks[25], (DEPTH, E, F, D)),
        'b_dn': 0.02 * nrm(ks[26], (DEPTH, E, D)),
    }


def reference(x, c, ctx, c_ctx, w_ada, b_ada, norm_mix_pre, norm_mix_post, norm_ffn_pre, norm_ffn_post,
              w_in, b_in, conv_w, lb_raw, m_norm, h_norm, w_pa, w_pb, w_out,
              w_router, b_router, w_gu, b_gu, w_dn, b_dn):
    lb_all = jnp.cumsum(jax.nn.softmax(lb_raw.astype(jnp.float32), axis=0), axis=0)
    for l in range(DEPTH):
        last = l == DEPTH - 1
        sh1, sc1, g1, sh2, sc2, g2 = ada_mod(c, w_ada[l], b_ada[l])
        csh1, csc1, cg1, csh2, csc2, cg2 = ada_mod(c_ctx[None, :], w_ada[l], b_ada[l])
        hl = modulate(rmsnorm(x, norm_mix_pre[l]), sh1, sc1)
        hc = modulate(rmsnorm(ctx, norm_mix_pre[l]), csh1, csc1)
        yl, yc = token_mixer(hl, hc, w_in[l], b_in[l], conv_w[l], lb_all[l], m_norm[l], h_norm[l],
                             w_pa[l], w_pb[l], w_out[l], not last)
        x = x + g1[:, None, :] * rmsnorm(yl, norm_mix_post[l])
        hl = modulate(rmsnorm(x, norm_ffn_pre[l]), sh2, sc2)
        x = x + g2[:, None, :] * rmsnorm(moe_ffn(hl, w_router[l], b_router[l], w_gu[l], b_gu[l], w_dn[l], b_dn[l]),
                                         norm_ffn_post[l])
        if not last:
            ctx = ctx + cg1[:, None, :] * rmsnorm(yc, norm_mix_post[l])
            hc = modulate(rmsnorm(ctx, norm_ffn_pre[l]), csh2, csc2)
            ctx = ctx + cg2[:, None, :] * rmsnorm(
                moe_ffn(hc, w_router[l], b_router[l], w_gu[l], b_gu[l], w_dn[l], b_dn[l]), norm_ffn_post[l])
    return x
```

```cpp
#include <hip/hip_runtime.h>
#include <hip/hip_cooperative_groups.h>
#include <cstdio>
namespace cg = cooperative_groups;

#define LAS __attribute__((address_space(3)))
typedef unsigned short bf16_t;
typedef short bf16x8 __attribute__((ext_vector_type(8)));
typedef float f32x4 __attribute__((ext_vector_type(4)));
typedef float f32x2 __attribute__((ext_vector_type(2)));
typedef unsigned u32x4 __attribute__((ext_vector_type(4)));
typedef unsigned u32x2 __attribute__((ext_vector_type(2)));

constexpr int D = 1024, NB = 16, T = 2048, TC = 256;
constexpr int NTOK = NB * T, NCTX = NB * TC, MROWS = NTOK + NCTX;
constexpr int NIN = 6672, NP = 6656;
constexpr int C_MQ = 0, C_MK = 512, C_MV = 1024, C_MO = 1536, C_HQ = 2048, C_HI = 2560, C_HG = 3072, C_HF = 3584, C_GA = 4608, C_GB = 5632, C_MG = 6656;
constexpr int NE = 32, TOPK = 4, PMAX = NTOK * TOPK + NE * 256, MAXBLK = PMAX / 256;
constexpr float EPS = 1e-6f;
constexpr int NPHASE = 14;
constexpr int LDS_STAGE = 131072, LDS_BYTES = LDS_STAGE + 16384;

constexpr size_t al256(size_t x) { return (x + 255) & ~(size_t)255; }
constexpr size_t WS_WIN = 0;
constexpr size_t WS_WPAB = WS_WIN + (size_t)NP * D * 2;
constexpr size_t WS_WOUT = WS_WPAB + (size_t)D * D * 2;
constexpr size_t WS_WGU = WS_WOUT + (size_t)D * D * 2;
constexpr size_t WS_WDN = WS_WGU + (size_t)NE * 2048 * D * 2;
constexpr size_t WS_MOD = WS_WDN + (size_t)NE * D * D * 2;
constexpr size_t WS_MG = al256(WS_MOD + 17 * 6144 * 4);
constexpr size_t WS_TOPE = al256(WS_MG + (size_t)MROWS * 16 * 4);
constexpr size_t WS_TOPW = WS_TOPE + (size_t)NTOK * 4 * 4;
constexpr size_t WS_DEST = WS_TOPW + (size_t)NTOK * 4 * 4;
constexpr size_t WS_PW = WS_DEST + (size_t)NTOK * 4 * 4;
constexpr size_t WS_CNT = al256(WS_PW + (size_t)PMAX * 4);
constexpr size_t WS_TAB = WS_CNT + 256 * 32 * 4;
constexpr size_t WS_HL = WS_TAB + 4096;
constexpr size_t WS_BIG = WS_HL + (size_t)MROWS * D * 2;
constexpr size_t WS_P = WS_BIG;
constexpr size_t WS_QK = WS_P + (size_t)MROWS * NP * 2;
constexpr size_t WS_HS = WS_QK + (size_t)MROWS * D * 2;
constexpr size_t WS_AB = WS_QK;
constexpr size_t WS_Y = WS_HS + (size_t)4 * NTOK * 512 * 2;
constexpr size_t WS_YL = WS_P;
constexpr size_t WS_XB = WS_BIG;
constexpr size_t WS_ACT = WS_XB + (size_t)PMAX * D * 2;
constexpr size_t WS_YB = WS_XB;
constexpr size_t WS_END1 = WS_Y + (size_t)NTOK * D * 2;
constexpr size_t WS_END2 = WS_ACT + (size_t)PMAX * D * 2;
constexpr size_t WS_END = WS_END1 > WS_END2 ? WS_END1 : WS_END2;
static_assert(WS_END <= (size_t)4 * 268435456, "workspace too large");

struct Params { const float* in[25]; float* out; unsigned char* ws; int ph_lo, ph_hi; };

__device__ __forceinline__ unsigned cvt_pk_bf16(float lo, float hi) { unsigned r; asm volatile("v_cvt_pk_bf16_f32 %0, %1, %2" : "=v"(r) : "v"(lo), "v"(hi)); return r; }
__device__ __forceinline__ float bf_lo(unsigned w) { return __uint_as_float(w << 16); }
__device__ __forceinline__ float bf_hi(unsigned w) { return __uint_as_float(w & 0xffff0000u); }
__device__ __forceinline__ float sigmoidf_(float x) { return 1.0f / (1.0f + __expf(-x)); }
__device__ __forceinline__ float siluf_(float x) { return x / (1.0f + __expf(-x)); }
__device__ __forceinline__ float wave_sum(float v) {
#pragma unroll
    for (int o = 1; o < 64; o <<= 1) v += __shfl_xor(v, o);
    return v;
}
__device__ __forceinline__ void unpack8(const u32x4 w, float (&f)[8]) {
    f[0] = bf_lo(w.x); f[1] = bf_hi(w.x); f[2] = bf_lo(w.y); f[3] = bf_hi(w.y); f[4] = bf_lo(w.z); f[5] = bf_hi(w.z); f[6] = bf_lo(w.w); f[7] = bf_hi(w.w);
}
__device__ __forceinline__ u32x4 pack8(const float (&f)[8]) {
    u32x4 w; w.x = cvt_pk_bf16(f[0], f[1]); w.y = cvt_pk_bf16(f[2], f[3]); w.z = cvt_pk_bf16(f[4], f[5]); w.w = cvt_pk_bf16(f[6], f[7]); return w;
}

namespace pg8 {
constexpr int BM = 256, BK = 64, HALF = 128, HTB = HALF * BK * 2, STAGE_BYTES = 8 * HTB, NXCD = 8, WGM = 8;
__device__ __forceinline__ int lds_byte(int r, int c) { const int st = (r >> 4) * 2 + (c >> 5), rr = r & 15, cc = c & 31, ob = rr * 64 + cc * 2; return st * 1024 + (ob ^ (((ob >> 9) & 1) << 5)); }
__device__ __forceinline__ void stage_rc(int b, int& R, int& C) { const int st = b / 1024, sb = b % 1024, swz = sb ^ (((sb >> 9) & 1) << 5); R = (st >> 1) * 16 + swz / 64; C = (st & 1) * 32 + (swz % 64) / 2; }
__device__ __forceinline__ int perm32(int rho) { const int n = rho >> 4, i = rho & 15; return 8 * (i >> 2) + 4 * n + (i & 3); }

struct Unit { int pm, pn, pb, e; };
struct Gemm { const bf16_t* A; const bf16_t* Bt; int K; };

__device__ __forceinline__ void static_map(int wgid, int nM, int nN, int& pm, int& pn) {
    const int nwg = nM * nN;
    { const int q = nwg / NXCD, r = nwg % NXCD, xcd = wgid % NXCD, off = wgid / NXCD; wgid = (xcd < r ? xcd * (q + 1) : r * (q + 1) + (xcd - r) * q) + off; }
    const int nig = WGM * nN, gid = wgid / nig, fm = gid * WGM, gsz = (nM - fm) < WGM ? (nM - fm) : WGM;
    pm = fm + ((wgid % nig) % gsz); pn = (wgid % nig) / gsz;
}
struct StaticOrder {
    int nM, nN, G, c;
    __device__ __forceinline__ bool next(int i, Unit& u) const {
        const int L = i * G + c; if (L >= nM * nN) return false;
        static_map(L, nM, nN, u.pm, u.pn); u.pb = u.pn; u.e = 0; return true;
    }
};
struct OrderP {
    int G, c;
    __device__ __forceinline__ bool next(int i, Unit& u) const {
        const int L = i * G + c;
        if (L < 128 * 26) { static_map(L, 128, 26, u.pm, u.pn); }
        else { const int r = L - 128 * 26; if (r >= 160) return false; const int q = r >> 4; u.pm = 128 + (r & 15); u.pn = q < 4 ? 2 + q : (q < 6 ? 6 + q : 8 + q); }
        u.pb = u.pn; u.e = 0; return true;
    }
};
struct OrderMoe {
    int G, c, nN; const LAS int* tab;
    __device__ __forceinline__ bool next(int i, Unit& u) const {
        const int L = i * G + c, pm = L / nN, pn = L - pm * nN;
        const int nblk = __builtin_amdgcn_readfirstlane(tab[0]);
        if (pm >= nblk) return false;
        const int e = __builtin_amdgcn_readfirstlane(tab[1 + pm]);
        u.pm = pm; u.pn = pn; u.pb = e * nN + pn; u.e = e; return true;
    }
};

template <class Epi, class Sched>
__device__ __forceinline__ void gemm_phase(LAS unsigned char* lds, const Gemm g, const Sched& S, const Epi& E) {
    const int tid = threadIdx.x, wid = __builtin_amdgcn_readfirstlane(tid >> 6), lane = tid & 63, wr = wid >> 2, wc = wid & 3, fr = lane & 15, fq = lane >> 4;
    const int K = g.K, nt = K / BK;
    unsigned voffA[2], voffB[2];
#pragma unroll
    for (int i = 0; i < 2; ++i) { int R, C; stage_rc(tid * 16 + i * 8192, R, C); const int Rb = Epi::PERM ? ((R & ~31) + perm32(R & 31)) : R;
        voffA[i] = (unsigned)(R * K + C) * 2u; voffB[i] = (unsigned)(Rb * K + C) * 2u; }
    const size_t kstep = (size_t)(BK * 2);
    const size_t hstep = (size_t)HALF * K * 2;
    const size_t tstep = 2 * hstep;
    const unsigned ldsw = (unsigned)wid * 1024u;
    const int aoff = lds_byte(wr * 64 + fr, fq * 8), boff = lds_byte(wc * 32 + fr, fq * 8);
#define PG8_SA(b, h) (((b) * 2 + (h)) * HTB)
#define PG8_SB(b, h) ((4 + (b) * 2 + (h)) * HTB)
#define PG8_STAGE(bufoff, gbase, voff) do { _Pragma("unroll") for (int _i = 0; _i < 2; ++_i) \
        __builtin_amdgcn_global_load_lds((const unsigned*)((const char*)(gbase) + (voff)[_i]), (LAS unsigned*)(lds + (bufoff) + ldsw + _i * 8192), 16, 0, 0); } while (0)
#define PG8_LDA(dst, b, h) do { _Pragma("unroll") for (int m = 0; m < 4; ++m) _Pragma("unroll") for (int k = 0; k < 2; ++k) dst[m][k] = *(const LAS bf16x8*)(lds + PG8_SA(b, h) + aoff + m * 2048 + k * 1024); } while (0)
#define PG8_LDB(dst, b, h) do { _Pragma("unroll") for (int n = 0; n < 2; ++n) _Pragma("unroll") for (int k = 0; k < 2; ++k) dst[n][k] = *(const LAS bf16x8*)(lds + PG8_SB(b, h) + boff + n * 2048 + k * 1024); } while (0)
#define PG8_MMA(ai, bj, At, Bt) do { __builtin_amdgcn_s_setprio(1); _Pragma("unroll") for (int m = 0; m < 4; ++m) _Pragma("unroll") for (int n = 0; n < 2; ++n) _Pragma("unroll") for (int k = 0; k < 2; ++k) \
        acc[ai][bj][m][n] = __builtin_amdgcn_mfma_f32_16x16x32_bf16(Bt[n][k], At[m][k], acc[ai][bj][m][n], 0, 0, 0); __builtin_amdgcn_s_setprio(0); } while (0)
#define PG8_WAIT_V(n) asm volatile("s_waitcnt vmcnt(" #n ")" ::: "memory")
#define PG8_WAIT_L(n) asm volatile("s_waitcnt lgkmcnt(" #n ")" ::: "memory")
#define PG8_BAR __builtin_amdgcn_s_barrier()
#define PG8_SCHED __builtin_amdgcn_sched_barrier(0)
    Unit cur, nxt; int ui = 0;
    if (!S.next(0, cur)) return;
    f32x4 acc[2][2][4][2];
#pragma unroll
    for (int a = 0; a < 2; ++a)
#pragma unroll
        for (int b = 0; b < 2; ++b)
#pragma unroll
            for (int m = 0; m < 4; ++m)
#pragma unroll
                for (int n = 0; n < 2; ++n) acc[a][b][m][n] = (f32x4){0.f, 0.f, 0.f, 0.f};
    bf16x8 At[4][2], B0[2][2], B1[2][2];
    const char* cA = (const char*)g.A + (size_t)cur.pm * tstep; const char* cB = (const char*)g.Bt + (size_t)cur.pb * tstep;
    PG8_STAGE(PG8_SB(0, 0), cB, voffB); PG8_STAGE(PG8_SA(0, 0), cA, voffA); PG8_STAGE(PG8_SB(0, 1), cB + hstep, voffB); PG8_STAGE(PG8_SA(0, 1), cA + hstep, voffA);
    if (wr == 1) PG8_BAR;
    PG8_WAIT_V(4); PG8_BAR;
    PG8_STAGE(PG8_SB(1, 0), cB + kstep, voffB); PG8_STAGE(PG8_SA(1, 0), cA + kstep, voffA); PG8_STAGE(PG8_SB(1, 1), cB + hstep + kstep, voffB);
    PG8_WAIT_V(6); PG8_BAR;
    for (;;) {
        const bool has_next = S.next(ui + 1, nxt);
        const char* nA = has_next ? (const char*)g.A + (size_t)nxt.pm * tstep : cA; const char* nB = has_next ? (const char*)g.Bt + (size_t)nxt.pb * tstep : cB;
        for (int t = 0; t < nt; t += 2) {
            const bool last = (t == nt - 2);
            const char* a1 = cA + (size_t)(t + 1) * kstep;
            const char* a2 = last ? nA : cA + (size_t)(t + 2) * kstep; const char* b2 = last ? nB : cB + (size_t)(t + 2) * kstep;
            const char* a3 = a2 + kstep; const char* b3 = b2 + kstep;
            PG8_LDB(B0, 0, 0); PG8_SCHED; PG8_LDA(At, 0, 0); PG8_STAGE(PG8_SA(1, 1), a1 + hstep, voffA);
            PG8_WAIT_L(8); PG8_BAR; PG8_WAIT_L(0); PG8_MMA(0, 0, At, B0); PG8_BAR; PG8_SCHED;
            PG8_LDB(B1, 0, 1); PG8_STAGE(PG8_SB(0, 0), b2, voffB);
            PG8_BAR; PG8_WAIT_L(0); PG8_MMA(0, 1, At, B1); PG8_BAR;
            PG8_LDA(At, 0, 1); PG8_STAGE(PG8_SA(0, 0), a2, voffA);
            PG8_BAR; PG8_WAIT_L(0); PG8_MMA(1, 0, At, B0); PG8_BAR; PG8_SCHED;
            PG8_STAGE(PG8_SB(0, 1), b2 + hstep, voffB);
            PG8_WAIT_V(6); PG8_BAR; PG8_MMA(1, 1, At, B1); PG8_BAR;
            PG8_LDB(B0, 1, 0); PG8_SCHED; PG8_LDA(At, 1, 0); PG8_STAGE(PG8_SA(0, 1), a2 + hstep, voffA);
            PG8_WAIT_L(8); PG8_BAR; PG8_WAIT_L(0); PG8_MMA(0, 0, At, B0); PG8_BAR; PG8_SCHED;
            PG8_LDB(B1, 1, 1); PG8_STAGE(PG8_SB(1, 0), b3, voffB);
            PG8_BAR; PG8_WAIT_L(0); PG8_MMA(0, 1, At, B1); PG8_BAR;
            PG8_LDA(At, 1, 1); PG8_STAGE(PG8_SA(1, 0), a3, voffA);
            PG8_BAR; PG8_WAIT_L(0); PG8_MMA(1, 0, At, B0); PG8_BAR; PG8_SCHED;
            PG8_STAGE(PG8_SB(1, 1), b3 + hstep, voffB);
            PG8_WAIT_V(6); PG8_BAR; PG8_MMA(1, 1, At, B1); PG8_BAR;
        }
        E(acc, cur, wr, wc, fr, fq);
        if (!has_next) break;
#pragma unroll
        for (int a = 0; a < 2; ++a)
#pragma unroll
            for (int b = 0; b < 2; ++b)
#pragma unroll
                for (int m = 0; m < 4; ++m)
#pragma unroll
                    for (int n = 0; n < 2; ++n) acc[a][b][m][n] = (f32x4){0.f, 0.f, 0.f, 0.f};
        cur = nxt; cA = nA; cB = nB; ++ui;
    }
    PG8_WAIT_V(0);
    if (wr == 0) PG8_BAR;
    PG8_BAR;
#undef PG8_SA
#undef PG8_SB
#undef PG8_STAGE
#undef PG8_LDA
#undef PG8_LDB
#undef PG8_MMA
#undef PG8_WAIT_V
#undef PG8_WAIT_L
#undef PG8_BAR
#undef PG8_SCHED
}

struct EpiF32 {
    static constexpr bool PERM = false, MID = false;
    float* C; int ldc;
    __device__ __forceinline__ void operator()(const f32x4 (&acc)[2][2][4][2], const Unit& u, int wr, int wc, int fr, int fq) const {
        const int row0 = u.pm * BM + wr * 64 + fr, col0 = u.pn * BM + wc * 32 + 4 * fq;
#pragma unroll
        for (int ai = 0; ai < 2; ++ai)
#pragma unroll
            for (int m = 0; m < 4; ++m) { float* rowp = C + (size_t)(row0 + ai * HALF + m * 16) * ldc + col0;
#pragma unroll
                for (int bj = 0; bj < 2; ++bj)
#pragma unroll
                    for (int n = 0; n < 2; ++n) *(f32x4*)(rowp + bj * HALF + n * 16) = acc[ai][bj][m][n]; }
    }
};
struct EpiP {
    static constexpr bool PERM = true, MID = false;
    bf16_t* P; const float* b_in; const float* lb_raw;
    __device__ __forceinline__ void operator()(const f32x4 (&acc)[2][2][4][2], const Unit& u, int wr, int wc, int fr, int fq) const {
        const int row0 = u.pm * BM + wr * 64 + fr, col0 = u.pn * BM + wc * 32 + 8 * fq;
        const int pn = u.pn;
        const int kind = (pn >= 6 && pn < 8) ? 1 : ((pn >= 8 && pn < 10) || (pn >= 12 && pn < 14)) ? 2 : (pn >= 14 && pn < 18) ? 3 : (pn >= 18) ? 1 : 0;
        f32x4 bv[2][2], lbv[2][2];
#pragma unroll
        for (int bj = 0; bj < 2; ++bj)
#pragma unroll
            for (int n = 0; n < 2; ++n) {
                const int c = col0 + bj * HALF + 4 * n;
                bv[bj][n] = *(const f32x4*)(b_in + c);
                lbv[bj][n] = (f32x4){0.f, 0.f, 0.f, 0.f};
                if (kind == 3) { const int cc = c - C_HF; const f32x4 r0 = *(const f32x4*)(lb_raw + cc), r1 = *(const f32x4*)(lb_raw + 1024 + cc);
#pragma unroll
                    for (int j = 0; j < 4; ++j) lbv[bj][n][j] = 1.0f - 1.0f / (1.0f + __expf(r1[j] - r0[j])); }
            }
#pragma unroll
        for (int ai = 0; ai < 2; ++ai)
#pragma unroll
            for (int m = 0; m < 4; ++m) { bf16_t* rowp = P + (size_t)(row0 + ai * HALF + m * 16) * NP + col0;
#pragma unroll
                for (int bj = 0; bj < 2; ++bj) { f32x4 v0 = acc[ai][bj][m][0] + bv[bj][0], v1 = acc[ai][bj][m][1] + bv[bj][1];
                    if (kind == 1) {
#pragma unroll
                        for (int j = 0; j < 4; ++j) { v0[j] = sigmoidf_(v0[j]); v1[j] = sigmoidf_(v1[j]); } }
                    else if (kind == 2) {
#pragma unroll
                        for (int j = 0; j < 4; ++j) { v0[j] = siluf_(v0[j]); v1[j] = siluf_(v1[j]); } }
                    else if (kind == 3) {
#pragma unroll
                        for (int j = 0; j < 4; ++j) { v0[j] = lbv[bj][0][j] / (1.0f + __expf(v0[j])); v1[j] = lbv[bj][1][j] / (1.0f + __expf(v1[j])); } }
                    u32x4 w; w.x = cvt_pk_bf16(v0[0], v0[1]); w.y = cvt_pk_bf16(v0[2], v0[3]); w.z = cvt_pk_bf16(v1[0], v1[1]); w.w = cvt_pk_bf16(v1[2], v1[3]);
                    *(u32x4*)(rowp + bj * HALF) = w; } }
    }
};
template <bool FIRST> struct EpiY {
    static constexpr bool PERM = true, MID = false;
    bf16_t* Y; const bf16_t* P;
    __device__ __forceinline__ void operator()(const f32x4 (&acc)[2][2][4][2], const Unit& u, int wr, int wc, int fr, int fq) const {
        const int row0 = u.pm * BM + wr * 64 + fr, col0 = u.pn * BM + wc * 32 + 8 * fq;
#pragma unroll
        for (int ai = 0; ai < 2; ++ai)
#pragma unroll
            for (int m = 0; m < 4; ++m) { const size_t r = (size_t)(row0 + ai * HALF + m * 16);
#pragma unroll
                for (int bj = 0; bj < 2; ++bj) { const u32x4 gg = *(const u32x4*)(P + r * NP + col0 + (FIRST ? C_GA : C_GB) + bj * HALF);
                    float b[8], o[8]; unpack8(gg, b); const f32x4 v0 = acc[ai][bj][m][0], v1 = acc[ai][bj][m][1];
                    if (FIRST) {
#pragma unroll
                        for (int j = 0; j < 8; ++j) o[j] = 0.f; }
                    else { const u32x4 prev = *(const u32x4*)(Y + r * D + col0 + bj * HALF); unpack8(prev, o); }
#pragma unroll
                    for (int j = 0; j < 4; ++j) { o[j] += v0[j] * b[j]; o[4 + j] += v1[j] * b[4 + j]; }
                    *(u32x4*)(Y + r * D + col0 + bj * HALF) = pack8(o); }
                asm volatile("" ::: "memory"); }
    }
};
struct EpiAct {
    static constexpr bool PERM = true, MID = false;
    bf16_t* ACT; const float* b_gu;
    __device__ __forceinline__ void operator()(const f32x4 (&acc)[2][2][4][2], const Unit& u, int wr, int wc, int fr, int fq) const {
        const int row0 = u.pm * BM + wr * 64 + fr, col0 = u.pn * HALF + wc * 32 + 8 * fq;
        const float* bg = b_gu + (size_t)u.e * 2048 + col0;
        const f32x4 bg0 = *(const f32x4*)(bg), bg1 = *(const f32x4*)(bg + 4), bu0 = *(const f32x4*)(bg + 1024), bu1 = *(const f32x4*)(bg + 1028);
#pragma unroll
        for (int ai = 0; ai < 2; ++ai)
#pragma unroll
            for (int m = 0; m < 4; ++m) {
                const f32x4 g0 = acc[ai][0][m][0] + bg0, g1 = acc[ai][0][m][1] + bg1, u0 = acc[ai][1][m][0] + bu0, u1 = acc[ai][1][m][1] + bu1;
                float o[8];
#pragma unroll
                for (int j = 0; j < 4; ++j) {
                    { const float g = fminf(g0[j], 7.0f), up = fminf(fmaxf(u0[j], -7.0f), 7.0f); o[j] = (up + 1.0f) * g / (1.0f + __expf(-1.702f * g)); }
                    { const float g = fminf(g1[j], 7.0f), up = fminf(fmaxf(u1[j], -7.0f), 7.0f); o[4 + j] = (up + 1.0f) * g / (1.0f + __expf(-1.702f * g)); } }
                *(u32x4*)(ACT + (size_t)(row0 + ai * HALF + m * 16) * D + col0) = pack8(o); }
    }
};
struct EpiDown {
    static constexpr bool PERM = true, MID = false;
    bf16_t* YB; const float* b_dn; const float* pw;
    __device__ __forceinline__ void operator()(const f32x4 (&acc)[2][2][4][2], const Unit& u, int wr, int wc, int fr, int fq) const {
        const int row0 = u.pm * BM + wr * 64 + fr, col0 = u.pn * BM + wc * 32 + 8 * fq;
        f32x4 bv[2][2];
#pragma unroll
        for (int bj = 0; bj < 2; ++bj)
#pragma unroll
            for (int n = 0; n < 2; ++n) bv[bj][n] = *(const f32x4*)(b_dn + (size_t)u.e * D + col0 + bj * HALF + 4 * n);
#pragma unroll
        for (int ai = 0; ai < 2; ++ai)
#pragma unroll
            for (int m = 0; m < 4; ++m) { const size_t r = (size_t)(row0 + ai * HALF + m * 16); const float w = pw[r];
#pragma unroll
                for (int bj = 0; bj < 2; ++bj) { const f32x4 v0 = (acc[ai][bj][m][0] + bv[bj][0]) * w, v1 = (acc[ai][bj][m][1] + bv[bj][1]) * w;
                    u32x4 o; o.x = cvt_pk_bf16(v0[0], v0[1]); o.y = cvt_pk_bf16(v0[2], v0[3]); o.z = cvt_pk_bf16(v1[0], v1[1]); o.w = cvt_pk_bf16(v1[2], v1[3]);
                    *(u32x4*)(YB + r * D + col0 + bj * HALF) = o; } }
    }
};
}

__device__ __forceinline__ void transpose_item(const float* src, int ld, bf16_t* dst, int ldd, LAS float* scr, int lane) {
#pragma unroll 8
    for (int i = 0; i < 32; ++i) { const int kk = 2 * i + (lane >> 5); scr[kk * 33 + (lane & 31)] = src[(size_t)kk * ld + (lane & 31)]; }
    asm volatile("s_waitcnt lgkmcnt(0)" ::: "memory");
    const int c = lane & 7;
#pragma unroll
    for (int j = 0; j < 4; ++j) { const int n = (lane >> 3) + 8 * j; const LAS float* s = scr + (8 * c) * 33 + n;
        u32x4 o; o.x = cvt_pk_bf16(s[0 * 33], s[1 * 33]); o.y = cvt_pk_bf16(s[2 * 33], s[3 * 33]); o.z = cvt_pk_bf16(s[4 * 33], s[5 * 33]); o.w = cvt_pk_bf16(s[6 * 33], s[7 * 33]);
        *(u32x4*)(dst + (size_t)n * ldd + 8 * c) = o; }
    asm volatile("s_waitcnt lgkmcnt(0)" ::: "memory");
}
__device__ __forceinline__ void ph_setup(const Params& p, LAS unsigned char* lds) {
    const int tid = threadIdx.x, lane = tid & 63, wave = __builtin_amdgcn_readfirstlane(tid >> 6);
    {
        LAS float* sT = (LAS float*)lds;
        LAS float* red = (LAS float*)(lds + 81920);
        const float* c = p.in[1]; const float* cctx = p.in[3]; const float* w_ada = p.in[4]; const float* b_ada = p.in[5];
        float* mod = (float*)(p.ws + WS_MOD);
        bool did = false;
        for (int item = blockIdx.x; item < 192; item += gridDim.x) {
            if (!did) { for (int idx = tid; idx < 17 * 1024; idx += 512) { const int r = idx >> 10, k = idx & 1023; const float v = r < 16 ? c[r * 1024 + k] : cctx[k]; sT[k * 20 + r] = siluf_(v); } __syncthreads(); did = true; }
            const int col = tid & 31, ks = tid >> 5, j = item * 32 + col;
            float acc[17];
#pragma unroll
            for (int r = 0; r < 17; ++r) acc[r] = 0.f;
            for (int kk = 0; kk < 64; ++kk) { const int k = ks * 64 + kk; const float w = w_ada[(size_t)k * 6144 + j];
#pragma unroll
                for (int r = 0; r < 17; ++r) acc[r] += sT[k * 20 + r] * w; }
#pragma unroll
            for (int r = 0; r < 17; ++r) red[(ks * 17 + r) * 32 + col] = acc[r];
            __syncthreads();
            for (int o = tid; o < 17 * 32; o += 512) { const int r = o >> 5, cc = o & 31; float s = b_ada[item * 32 + cc];
                for (int k2 = 0; k2 < 16; ++k2) s += red[(k2 * 17 + r) * 32 + cc];
                mod[r * 6144 + item * 32 + cc] = s; }
            __syncthreads();
        }
        __syncthreads();
    }
    {
        LAS float* scr = (LAS float*)(lds + wave * 8704);
        const int gw = blockIdx.x * 8 + wave, NGW = gridDim.x * 8;
        constexpr int I_IN = 16 * 208, I_PA = 8 * 32, I_OUT = 16 * 32, I_GU = NE * 16 * 64, I_DN = NE * 16 * 32;
        constexpr int NITEMS = I_IN + 2 * I_PA + I_OUT + I_GU + I_DN;
        bf16_t* Wt_in = (bf16_t*)(p.ws + WS_WIN); bf16_t* Wt_pab = (bf16_t*)(p.ws + WS_WPAB); bf16_t* Wt_out = (bf16_t*)(p.ws + WS_WOUT);
        bf16_t* Wt_gu = (bf16_t*)(p.ws + WS_WGU); bf16_t* Wt_dn = (bf16_t*)(p.ws + WS_WDN);
        for (int it = gw; it < NITEMS; it += NGW) {
            int r = it;
            if (r < I_IN) { const int kb = r / 208, nb = r % 208; transpose_item(p.in[10] + (size_t)(64 * kb) * NIN + 32 * nb, NIN, Wt_in + (size_t)(32 * nb) * D + 64 * kb, D, scr, lane); continue; } r -= I_IN;
            if (r < I_PA) { const int kb = r / 32, nb = r % 32; transpose_item(p.in[16] + (size_t)(64 * kb) * D + 32 * nb, D, Wt_pab + (size_t)(32 * nb) * 512 + 64 * kb, 512, scr, lane); continue; } r -= I_PA;
            if (r < I_PA) { const int kb = r / 32, nb = r % 32; transpose_item(p.in[17] + (size_t)(64 * kb) * D + 32 * nb, D, Wt_pab + (size_t)D * 512 + (size_t)(32 * nb) * 512 + 64 * kb, 512, scr, lane); continue; } r -= I_PA;
            if (r < I_OUT) { const int kb = r / 32, nb = r % 32; transpose_item(p.in[18] + (size_t)(64 * kb) * D + 32 * nb, D, Wt_out + (size_t)(32 * nb) * D + 64 * kb, D, scr, lane); continue; } r -= I_OUT;
            if (r < I_GU) { const int e = r / 1024, q = r % 1024, kb = q / 64, nb = q % 64, n0 = 32 * nb, jj = n0 & 1023, half = n0 >> 10, row0 = (jj >> 7) * 256 + half * 128 + (jj & 127);
                transpose_item(p.in[21] + (size_t)e * D * 2048 + (size_t)(64 * kb) * 2048 + n0, 2048, Wt_gu + ((size_t)e * 2048 + row0) * D + 64 * kb, D, scr, lane); continue; } r -= I_GU;
            { const int e = r / 512, q = r % 512, kb = q / 32, nb = q % 32;
                transpose_item(p.in[23] + (size_t)e * D * D + (size_t)(64 * kb) * D + 32 * nb, D, Wt_dn + ((size_t)e * D + 32 * nb) * D + 64 * kb, D, scr, lane); }
        }
    }
}

__device__ __forceinline__ void ph_hl(const Params& p, LAS unsigned char* lds) {
    const int tid = threadIdx.x, lane = tid & 63, wave = __builtin_amdgcn_readfirstlane(tid >> 6);
    LAS float* wgT = (LAS float*)lds;
    const float* w_in = p.in[10];
    for (int idx = tid; idx < 16384; idx += 512) { const int k = idx >> 4, j = idx & 15; wgT[j * 1024 + k] = w_in[(size_t)k * NIN + C_MG + j]; }
    __syncthreads();
    const float* x = p.in[0]; const float* ctx = p.in[2]; const float* wpre = p.in[6]; const float* b_in = p.in[11];
    const float* mod = (const float*)(p.ws + WS_MOD); float* mg = (float*)(p.ws + WS_MG); bf16_t* HL = (bf16_t*)(p.ws + WS_HL);
    const int gw = blockIdx.x * 8 + wave, NGW = gridDim.x * 8;
    for (int r = gw; r < MROWS; r += NGW) {
        const float* src = r < NTOK ? x + (size_t)r * D : ctx + (size_t)(r - NTOK) * D;
        const int b = r < NTOK ? (r >> 11) : 16;
        const float* sh = mod + b * 6144; const float* sc = sh + 1024;
        f32x4 v[4]; float ss = 0.f;
#pragma unroll
        for (int j = 0; j < 4; ++j) { v[j] = ((const f32x4*)src)[lane + 64 * j]; ss += v[j].x * v[j].x + v[j].y * v[j].y + v[j].z * v[j].z + v[j].w * v[j].w; }
        ss = wave_sum(ss); const float rstd = rsqrtf(ss * (1.0f / D) + EPS);
        float part[16];
#pragma unroll
        for (int q = 0; q < 16; ++q) part[q] = 0.f;
#pragma unroll
        for (int j = 0; j < 4; ++j) { const int ci = 4 * lane + 256 * j;
            const f32x4 wv = *(const f32x4*)(wpre + ci), shv = *(const f32x4*)(sh + ci), scv = *(const f32x4*)(sc + ci);
            f32x4 h;
#pragma unroll
            for (int i = 0; i < 4; ++i) h[i] = v[j][i] * rstd * wv[i] * (1.0f + scv[i]) + shv[i];
            u32x2 o; o.x = cvt_pk_bf16(h[0], h[1]); o.y = cvt_pk_bf16(h[2], h[3]);
            *(u32x2*)(HL + (size_t)r * D + ci) = o;
#pragma unroll
            for (int q = 0; q < 16; ++q) { const f32x4 w4 = *(const LAS f32x4*)(wgT + q * 1024 + ci); part[q] += h[0] * w4[0] + h[1] * w4[1] + h[2] * w4[2] + h[3] * w4[3]; }
        }
        int n = 16;
#pragma unroll
        for (int msk = 32; msk >= 4; msk >>= 1) { n >>= 1; const bool up = (lane & msk) != 0;
#pragma unroll
            for (int i = 0; i < 8; ++i) if (i < n) { const float a = part[i], bq = part[i + n]; const float send = up ? a : bq, keep = up ? bq : a; part[i] = keep + __shfl_xor(send, msk); } }
        float tot = part[0]; tot += __shfl_xor(tot, 2); tot += __shfl_xor(tot, 1);
        const int idx = ((lane >> 5) & 1) * 8 + ((lane >> 4) & 1) * 4 + ((lane >> 3) & 1) * 2 + ((lane >> 2) & 1);
        if ((lane & 3) == 0) mg[(size_t)r * 16 + idx] = tot + b_in[C_MG + idx];
    }
}

__device__ __forceinline__ void ph_conv(const Params& p) {
    const bf16_t* P = (const bf16_t*)(p.ws + WS_P); bf16_t* QK = (bf16_t*)(p.ws + WS_QK); const float* cw = p.in[12];
    const int gt = blockIdx.x * 512 + threadIdx.x, NT = gridDim.x * 512;
    {
        const int cg8 = gt & 127, c0 = cg8 * 8;
        float w[9][8];
#pragma unroll
        for (int t = 0; t < 9; ++t) { const f32x4 a = *(const f32x4*)(cw + t * 1024 + c0), b = *(const f32x4*)(cw + t * 1024 + c0 + 4);
#pragma unroll
            for (int i = 0; i < 4; ++i) { w[t][i] = a[i]; w[t][4 + i] = b[i]; } }
        const float osc = c0 < 512 ? 0.08838834764831845f : 1.0f;
        for (int tok = gt >> 7; tok < NTOK; tok += NT >> 7) {
            const int b = tok >> 11, t = tok & 2047, gi = t >> 6, gj = t & 63;
            float acc[8];
#pragma unroll
            for (int i = 0; i < 8; ++i) acc[i] = 0.f;
#pragma unroll
            for (int di = 0; di < 3; ++di)
#pragma unroll
                for (int dj = 0; dj < 3; ++dj) { const int ii = gi + di - 1, jj = gj + dj - 1;
                    if (ii >= 0 && ii < 32 && jj >= 0 && jj < 64) { const u32x4 raw = *(const u32x4*)(P + (size_t)(b * 2048 + ii * 64 + jj) * NP + c0); float f[8]; unpack8(raw, f);
#pragma unroll
                        for (int i = 0; i < 8; ++i) acc[i] += w[di * 3 + dj][i] * f[i]; } }
#pragma unroll
            for (int i = 0; i < 8; ++i) acc[i] = siluf_(acc[i]) * osc;
            *(u32x4*)(QK + (size_t)tok * D + c0) = pack8(acc);
        }
    }
    {
        const int cg8 = gt & 63, c0 = 512 + cg8 * 8;
        float w[3][8];
#pragma unroll
        for (int t = 0; t < 3; ++t) { const f32x4 a = *(const f32x4*)(cw + (3 + t) * 1024 + c0), b = *(const f32x4*)(cw + (3 + t) * 1024 + c0 + 4);
#pragma unroll
            for (int i = 0; i < 4; ++i) { w[t][i] = a[i]; w[t][4 + i] = b[i]; } }
        for (int tok = gt >> 6; tok < NCTX; tok += NT >> 6) {
            const int t = tok & 255;
            float acc[8];
#pragma unroll
            for (int i = 0; i < 8; ++i) acc[i] = 0.f;
#pragma unroll
            for (int dj = 0; dj < 3; ++dj) { const int jj = t + dj - 1;
                if (jj >= 0 && jj < 256) { const u32x4 raw = *(const u32x4*)(P + (size_t)(NTOK + tok + dj - 1) * NP + c0); float f[8]; unpack8(raw, f);
#pragma unroll
                    for (int i = 0; i < 8; ++i) acc[i] += w[dj][i] * f[i]; } }
#pragma unroll
            for (int i = 0; i < 8; ++i) acc[i] = siluf_(acc[i]);
            *(u32x4*)(QK + (size_t)(NTOK + tok) * D + c0) = pack8(acc);
        }
    }
}

template <bool MLSTM>
__device__ __forceinline__ void scan_item(const Params& p, LAS unsigned char* lds, int b, int h, int dir) {
    const int tid = threadIdx.x, vv = tid >> 2, dq = tid & 3;
    LAS float* kS = (LAS float*)lds;
    LAS float* qS = kS + 4096;
    LAS float* vS = qS + 4096;
    LAS float* oS = vS + 4096;
    LAS float* gS = oS + 4096;
    const bf16_t* P = (const bf16_t*)(p.ws + WS_P); const bf16_t* QK = (const bf16_t*)(p.ws + WS_QK); const float* mg = (const float*)(p.ws + WS_MG);
    bf16_t* HS = (bf16_t*)(p.ws + WS_HS) + (size_t)((MLSTM ? 0 : 2) + dir) * NTOK * 512;
    float st[32], nn[32];
#pragma unroll
    for (int j = 0; j < 32; ++j) { st[j] = 0.f; nn[j] = 0.f; }
    const int ls = tid >> 4, lc = (tid & 15) * 8;
    for (int seg = 0; seg < 2; ++seg) {
        const int len = seg == 0 ? TC : T; const int rbase = seg == 0 ? NTOK + b * TC : b * T;
        for (int blk = 0; blk < len / 32; ++blk) {
            {
                const int sidx = blk * 32 + ls; const int t = dir ? (len - 1 - sidx) : sidx; const size_t row = (size_t)(rbase + t);
                u32x4 rk, rq, rv;
                if (MLSTM) { rk = *(const u32x4*)(QK + row * D + 512 + h * 128 + lc); rv = *(const u32x4*)(P + row * NP + C_MV + h * 128 + lc);
                    rq = seg ? *(const u32x4*)(QK + row * D + h * 128 + lc) : (u32x4){0u, 0u, 0u, 0u}; }
                else { rk = *(const u32x4*)(P + row * NP + C_HF + dir * 512 + h * 128 + lc); rv = *(const u32x4*)(P + row * NP + C_HI + h * 128 + lc);
                    rq = seg ? *(const u32x4*)(P + row * NP + C_HQ + h * 128 + lc) : (u32x4){0u, 0u, 0u, 0u}; }
                float f[8];
                unpack8(rk, f); *(LAS f32x4*)(kS + ls * 128 + lc) = (f32x4){f[0], f[1], f[2], f[3]}; *(LAS f32x4*)(kS + ls * 128 + lc + 4) = (f32x4){f[4], f[5], f[6], f[7]};
                unpack8(rq, f); *(LAS f32x4*)(qS + ls * 128 + lc) = (f32x4){f[0], f[1], f[2], f[3]}; *(LAS f32x4*)(qS + ls * 128 + lc + 4) = (f32x4){f[4], f[5], f[6], f[7]};
                unpack8(rv, f); *(LAS f32x4*)(vS + ls * 128 + lc) = (f32x4){f[0], f[1], f[2], f[3]}; *(LAS f32x4*)(vS + ls * 128 + lc + 4) = (f32x4){f[4], f[5], f[6], f[7]};
                if (MLSTM && tid < 32) { const int s2 = blk * 32 + tid; const int t2 = dir ? (len - 1 - s2) : s2; const float* g = mg + (size_t)(rbase + t2) * 16;
                    gS[tid * 2] = __expf(g[dir * 4 + h]); gS[tid * 2 + 1] = sigmoidf_(g[(2 + dir) * 4 + h]); }
            }
            __syncthreads();
            for (int s = 0; s < 32; ++s) {
                float num = 0.f, den = 0.f;
                if (MLSTM) {
                    const float w = gS[s * 2], f = gS[s * 2 + 1], wv = w * vS[s * 128 + vv];
#pragma unroll
                    for (int j4 = 0; j4 < 8; ++j4) { const f32x4 k4 = *(const LAS f32x4*)(kS + s * 128 + dq * 32 + 4 * j4), q4 = *(const LAS f32x4*)(qS + s * 128 + dq * 32 + 4 * j4);
#pragma unroll
                        for (int i = 0; i < 4; ++i) { const int j = 4 * j4 + i; st[j] = f * st[j] + wv * k4[i]; nn[j] = f * nn[j] + w * k4[i]; num += st[j] * q4[i]; den += nn[j] * q4[i]; } }
                } else {
                    const float iv = vS[s * 128 + vv];
#pragma unroll
                    for (int j4 = 0; j4 < 8; ++j4) { const f32x4 k4 = *(const LAS f32x4*)(kS + s * 128 + dq * 32 + 4 * j4), q4 = *(const LAS f32x4*)(qS + s * 128 + dq * 32 + 4 * j4);
#pragma unroll
                        for (int i = 0; i < 4; ++i) { const int j = 4 * j4 + i; st[j] = (1.0f - k4[i]) * st[j] + k4[i] * iv; num += st[j] * q4[i]; } }
                }
                if (seg) {
                    num += __shfl_xor(num, 1); num += __shfl_xor(num, 2);
                    if (MLSTM) { den += __shfl_xor(den, 1); den += __shfl_xor(den, 2); num = num / fmaxf(fabsf(den), 1.0f); }
                    if (dq == 0) oS[s * 128 + vv] = num;
                }
            }
            __syncthreads();
            if (seg) {
                const int sidx = blk * 32 + ls; const int t = dir ? (len - 1 - sidx) : sidx;
                const f32x4 a = *(const LAS f32x4*)(oS + ls * 128 + lc), c = *(const LAS f32x4*)(oS + ls * 128 + lc + 4);
                u32x4 o; o.x = cvt_pk_bf16(a[0], a[1]); o.y = cvt_pk_bf16(a[2], a[3]); o.z = cvt_pk_bf16(c[0], c[1]); o.w = cvt_pk_bf16(c[2], c[3]);
                *(u32x4*)(HS + (size_t)(rbase + t) * 512 + h * 128 + lc) = o;
            }
        }
    }
    __syncthreads();
}
__device__ __forceinline__ void ph_scan(const Params& p, LAS unsigned char* lds) {
    for (int item = blockIdx.x; item < 256; item += gridDim.x) {
        const int kind = item >> 7, r = item & 127, b = r >> 3, h = (r >> 1) & 3, dir = r & 1;
        if (kind == 0) scan_item<true>(p, lds, b, h, dir); else scan_item<false>(p, lds, b, h, dir);
    }
}

__device__ __forceinline__ void ph_merge(const Params& p) {
    const int lane = threadIdx.x & 63, wave = __builtin_amdgcn_readfirstlane(threadIdx.x >> 6);
    const bf16_t* P = (const bf16_t*)(p.ws + WS_P); const bf16_t* HS = (const bf16_t*)(p.ws + WS_HS); bf16_t* AB = (bf16_t*)(p.ws + WS_AB);
    const float* m_norm = p.in[14]; const float* h_norm = p.in[15];
    const int gw = blockIdx.x * 8 + wave, NGW = gridDim.x * 8, c0 = lane * 8;
    for (int tok = gw; tok < NTOK; tok += NGW) {
#pragma unroll
        for (int kind = 0; kind < 2; ++kind) {
            const u32x4 r0 = *(const u32x4*)(HS + ((size_t)(2 * kind) * NTOK + tok) * 512 + c0), r1 = *(const u32x4*)(HS + ((size_t)(2 * kind + 1) * NTOK + tok) * 512 + c0);
            const u32x4 rg = *(const u32x4*)(P + (size_t)tok * NP + (kind ? C_HG : C_MO) + c0);
            const float* nw = (kind ? h_norm : m_norm) + c0; const f32x4 w0 = *(const f32x4*)nw, w1 = *(const f32x4*)(nw + 4);
            float a[8], b[8], g[8]; unpack8(r0, a); unpack8(r1, b); unpack8(rg, g);
            float ss = 0.f;
#pragma unroll
            for (int i = 0; i < 8; ++i) { a[i] += b[i]; ss += a[i] * a[i]; }
            ss += __shfl_xor(ss, 1); ss += __shfl_xor(ss, 2); ss += __shfl_xor(ss, 4); ss += __shfl_xor(ss, 8);
            const float rstd = rsqrtf(ss * (1.0f / 128.0f) + EPS);
#pragma unroll
            for (int i = 0; i < 8; ++i) a[i] = a[i] * rstd * (i < 4 ? w0[i] : w1[i - 4]) * g[i];
            *(u32x4*)(AB + ((size_t)kind * NTOK + tok) * 512 + c0) = pack8(a);
        }
    }
}

__device__ __forceinline__ void ph_post(const Params& p, LAS unsigned char* lds) {
    const int tid = threadIdx.x, lane = tid & 63, wave = __builtin_amdgcn_readfirstlane(tid >> 6);
    LAS float* wrT = (LAS float*)lds;
    LAS float* vec = (LAS float*)(lds + LDS_STAGE);
    LAS int* hist = (LAS int*)(lds + LDS_STAGE + 12288);
    const float* w_router = p.in[19]; const float* b_router = p.in[20];
    for (int idx = tid; idx < 32768; idx += 512) { const int k = idx >> 5, e = idx & 31; wrT[e * 1024 + k] = w_router[idx]; }
    const float* x = p.in[0]; const float* wpost = p.in[7]; const float* wfpre = p.in[8];
    const float* mod = (const float*)(p.ws + WS_MOD); const float* YL = (const float*)(p.ws + WS_YL); bf16_t* HL2 = (bf16_t*)(p.ws + WS_HL);
    int* top_e = (int*)(p.ws + WS_TOPE); float* top_w = (float*)(p.ws + WS_TOPW); int* cntWG = (int*)(p.ws + WS_CNT);
    for (int blk = blockIdx.x; blk < 256; blk += gridDim.x) {
        const float* mb = mod + (blk >> 4) * 6144;
        for (int i = tid; i < 1024; i += 512) { vec[i] = mb[2048 + i] * wpost[i]; vec[1024 + i] = wfpre[i] * (1.0f + mb[4096 + i]); vec[2048 + i] = mb[3072 + i]; }
        if (tid < 32) hist[tid] = 0;
        __syncthreads();
#pragma unroll 1
        for (int tt = 0; tt < 16; ++tt) {
            const int tok = blk * 128 + wave * 16 + tt;
            const f32x4* yrow = (const f32x4*)(YL + (size_t)tok * D); const f32x4* xrow = (const f32x4*)(x + (size_t)tok * D); f32x4* orow = (f32x4*)(p.out + (size_t)tok * D);
            f32x4 yv[4], xv[4]; float ss = 0.f;
#pragma unroll
            for (int j = 0; j < 4; ++j) { yv[j] = yrow[lane + 64 * j]; xv[j] = xrow[lane + 64 * j];
                ss += yv[j].x * yv[j].x + yv[j].y * yv[j].y + yv[j].z * yv[j].z + yv[j].w * yv[j].w; }
            ss = wave_sum(ss); const float rstd = rsqrtf(ss * (1.0f / D) + EPS);
            float ss2 = 0.f;
#pragma unroll
            for (int j = 0; j < 4; ++j) { const f32x4 gw = *(const LAS f32x4*)(vec + 4 * lane + 256 * j);
#pragma unroll
                for (int i = 0; i < 4; ++i) { xv[j][i] = xv[j][i] + gw[i] * (yv[j][i] * rstd); ss2 += xv[j][i] * xv[j][i]; }
                orow[lane + 64 * j] = xv[j]; }
            ss2 = wave_sum(ss2); const float rstd2 = rsqrtf(ss2 * (1.0f / D) + EPS);
#pragma unroll
            for (int j = 0; j < 4; ++j) { const f32x4 a2 = *(const LAS f32x4*)(vec + 1024 + 4 * lane + 256 * j), s2 = *(const LAS f32x4*)(vec + 2048 + 4 * lane + 256 * j);
#pragma unroll
                for (int i = 0; i < 4; ++i) yv[j][i] = xv[j][i] * rstd2 * a2[i] + s2[i];
                u32x2 o; o.x = cvt_pk_bf16(yv[j][0], yv[j][1]); o.y = cvt_pk_bf16(yv[j][2], yv[j][3]);
                *(u32x2*)(HL2 + (size_t)tok * D + 4 * lane + 256 * j) = o; }
            asm volatile("" ::: "memory");
            float acc[32];
#pragma unroll
            for (int e = 0; e < 32; ++e) { float a = 0.f;
#pragma unroll
                for (int j = 0; j < 4; ++j) { const f32x4 w4 = *(const LAS f32x4*)(wrT + e * 1024 + 256 * j + 4 * lane); a += yv[j][0] * w4[0] + yv[j][1] * w4[1] + yv[j][2] * w4[2] + yv[j][3] * w4[3]; }
                acc[e] = a; if ((e & 3) == 3) asm volatile("" ::: "memory"); }
            int n = 32;
#pragma unroll
            for (int msk = 32; msk >= 2; msk >>= 1) { n >>= 1; const bool up = (lane & msk) != 0;
#pragma unroll
                for (int i = 0; i < 16; ++i) if (i < n) { const float a = acc[i], bq = acc[i + n]; const float send = up ? a : bq, keep = up ? bq : a; acc[i] = keep + __shfl_xor(send, msk); } }
            float cv = acc[0]; cv += __shfl_xor(cv, 1);
            const int ci = lane >> 1; cv += b_router[ci];
            float tv[4]; int ti[4];
#pragma unroll
            for (int k = 0; k < 4; ++k) { float bv = cv; int bi = ci;
#pragma unroll
                for (int o = 1; o < 64; o <<= 1) { const float ov = __shfl_xor(bv, o); const int oi = __shfl_xor(bi, o); const bool take = (ov > bv) || (ov == bv && oi < bi); bv = take ? ov : bv; bi = take ? oi : bi; }
                tv[k] = bv; ti[k] = bi; cv = (ci == bi) ? -3.0e38f : cv; }
            const float e1 = __expf(tv[1] - tv[0]), e2 = __expf(tv[2] - tv[0]), e3 = __expf(tv[3] - tv[0]); const float inv = 1.0f / (1.0f + e1 + e2 + e3);
            if (lane == 0) { *(int4*)(top_e + (size_t)tok * 4) = make_int4(ti[0], ti[1], ti[2], ti[3]); *(f32x4*)(top_w + (size_t)tok * 4) = (f32x4){inv, e1 * inv, e2 * inv, e3 * inv};
#pragma unroll
                for (int k = 0; k < 4; ++k) __hip_atomic_fetch_add(&hist[ti[k]], 1, __ATOMIC_RELAXED, __HIP_MEMORY_SCOPE_WORKGROUP); }
        }
        __syncthreads();
        if (tid < 32) cntWG[blk * 32 + tid] = hist[tid];
        __syncthreads();
    }
}

__device__ __forceinline__ void ph_scatter(const Params& p, LAS unsigned char* lds) {
    const int tid = threadIdx.x, lane = tid & 63, wave = __builtin_amdgcn_readfirstlane(tid >> 6);
    LAS int* sm = (LAS int*)lds;
    const int* cntWG = (const int*)(p.ws + WS_CNT); const int* top_e = (const int*)(p.ws + WS_TOPE); const float* top_w = (const float*)(p.ws + WS_TOPW);
    int* dest_arr = (int*)(p.ws + WS_DEST); float* pw = (float*)(p.ws + WS_PW); int* tab = (int*)(p.ws + WS_TAB);
    const bf16_t* HL2 = (const bf16_t*)(p.ws + WS_HL); bf16_t* XB = (bf16_t*)(p.ws + WS_XB);
    for (int blk = blockIdx.x; blk < 256; blk += gridDim.x) {
        if (tid < 32) { int tot = 0, bef = 0; for (int w = 0; w < 256; ++w) { const int c = cntWG[w * 32 + tid]; tot += c; bef += (w < blk) ? c : 0; } sm[tid] = tot; sm[32 + tid] = bef; }
        __syncthreads();
        if (tid == 0) { int run = 0; for (int e = 0; e < 32; ++e) { sm[96 + e] = run; sm[64 + e] = run + sm[32 + e]; run += (sm[e] + 255) & ~255; } if (blk == 0) tab[0] = run >> 8; }
        __syncthreads();
        if (blk == 0 && tid < 32) { const int b0 = sm[96 + tid] >> 8, nb = (sm[tid] + 255) >> 8; for (int i = 0; i < nb; ++i) tab[1 + b0 + i] = tid; }
        const int tok = blk * 128 + (tid >> 2), k = tid & 3;
        const int e = top_e[(size_t)tok * 4 + k];
        int rank = 0;
        for (int ee = 0; ee < 32; ++ee) { const unsigned long long mask = __ballot(e == ee); if (e == ee) rank = __popcll(mask & ((1ull << lane) - 1ull)); if (lane == 0) sm[128 + wave * 32 + ee] = __popcll(mask); }
        __syncthreads();
        int off = 0; for (int w = 0; w < wave; ++w) off += sm[128 + w * 32 + e];
        const int dest = sm[64 + e] + off + rank;
        dest_arr[(size_t)tok * 4 + k] = dest; pw[dest] = top_w[(size_t)tok * 4 + k];
        for (int i = 0; i < 64; ++i) { const int d = __shfl(dest, i); const int tk = blk * 128 + ((wave * 64 + i) >> 2);
            const u32x4* src = (const u32x4*)(HL2 + (size_t)tk * D); u32x4* dst = (u32x4*)(XB + (size_t)d * D);
            dst[lane] = src[lane]; dst[lane + 64] = src[lane + 64]; }
        __syncthreads();
    }
}

__device__ __forceinline__ void ph_combine(const Params& p) {
    const int lane = threadIdx.x & 63, wave = __builtin_amdgcn_readfirstlane(threadIdx.x >> 6);
    const bf16_t* YB = (const bf16_t*)(p.ws + WS_YB); const int* dest_arr = (const int*)(p.ws + WS_DEST); const float* mod = (const float*)(p.ws + WS_MOD); const float* wpost2 = p.in[9];
    const int gw = blockIdx.x * 8 + wave, NGW = gridDim.x * 8;
    for (int tok = gw; tok < NTOK; tok += NGW) {
        const int b = tok >> 11; const float* g2 = mod + b * 6144 + 5120;
        const int4 dd = *(const int4*)(dest_arr + (size_t)tok * 4); const int ds[4] = {dd.x, dd.y, dd.z, dd.w};
        float y[2][8];
#pragma unroll
        for (int s = 0; s < 2; ++s)
#pragma unroll
            for (int i = 0; i < 8; ++i) y[s][i] = 0.f;
#pragma unroll
        for (int k = 0; k < 4; ++k)
#pragma unroll
            for (int s = 0; s < 2; ++s) { const u32x4 r = *(const u32x4*)(YB + (size_t)ds[k] * D + s * 512 + lane * 8); float f[8]; unpack8(r, f);
#pragma unroll
                for (int i = 0; i < 8; ++i) y[s][i] += f[i]; }
        float ss = 0.f;
#pragma unroll
        for (int s = 0; s < 2; ++s)
#pragma unroll
            for (int i = 0; i < 8; ++i) ss += y[s][i] * y[s][i];
        ss = wave_sum(ss); const float rstd = rsqrtf(ss * (1.0f / D) + EPS);
#pragma unroll
        for (int s = 0; s < 2; ++s)
#pragma unroll
            for (int q = 0; q < 2; ++q) { const int ci = s * 512 + lane * 8 + 4 * q; float* op = p.out + (size_t)tok * D + ci;
                const f32x4 x1 = *(const f32x4*)op, gv = *(const f32x4*)(g2 + ci), wv = *(const f32x4*)(wpost2 + ci); f32x4 o;
#pragma unroll
                for (int i = 0; i < 4; ++i) o[i] = x1[i] + gv[i] * (y[s][4 * q + i] * rstd * wv[i]);
                *(f32x4*)op = o; }
    }
}

typedef const __attribute__((address_space(4))) Params* KParams;
__device__ __forceinline__ Params load_params() {
    Params q{};
#if defined(__HIP_DEVICE_COMPILE__)
    KParams kp = (KParams)__builtin_amdgcn_kernarg_segment_ptr(); asm volatile("" : "+s"(kp));
#pragma unroll
    for (int i = 0; i < 25; ++i) q.in[i] = kp->in[i];
    q.out = kp->out; q.ws = kp->ws; q.ph_lo = kp->ph_lo; q.ph_hi = kp->ph_hi;
#endif
    return q;
}
__global__ void __launch_bounds__(512, 2) mega_fwd(Params pk) {
    extern __shared__ __attribute__((aligned(16))) unsigned char lds_raw[];
    LAS unsigned char* lds = (LAS unsigned char*)lds_raw;
    cg::grid_group grid = cg::this_grid();
    const int G = gridDim.x, c = blockIdx.x;
#ifndef PHASE_MASK
#define PHASE_MASK 0x3fff
#endif
#define IN(k) (((PHASE_MASK >> (k)) & 1) && pk.ph_lo <= (k) && (k) < pk.ph_hi)
#define SEAM(k) do { if ((k) + 1 < pk.ph_hi) grid.sync(); } while (0)
    if (IN(0)) { const Params p = load_params(); ph_setup(p, lds); SEAM(0); }
    if (IN(1)) { const Params p = load_params(); ph_hl(p, lds); SEAM(1); }
    if (IN(2)) { const Params p = load_params(); pg8::Gemm g{(const bf16_t*)(p.ws + WS_HL), (const bf16_t*)(p.ws + WS_WIN), D}; pg8::OrderP S{G, c};
        pg8::EpiP E{(bf16_t*)(p.ws + WS_P), p.in[11], p.in[13]}; pg8::gemm_phase(lds, g, S, E); SEAM(2); }
    if (IN(3)) { const Params p = load_params(); ph_conv(p); SEAM(3); }
    if (IN(4)) { const Params p = load_params(); ph_scan(p, lds); SEAM(4); }
    if (IN(5)) { const Params p = load_params(); ph_merge(p); SEAM(5); }
    if (IN(6)) { const Params p = load_params(); pg8::Gemm g{(const bf16_t*)(p.ws + WS_AB), (const bf16_t*)(p.ws + WS_WPAB), 512}; pg8::StaticOrder S{NTOK / 256, 4, G, c};
        pg8::EpiY<true> E{(bf16_t*)(p.ws + WS_Y), (const bf16_t*)(p.ws + WS_P)}; pg8::gemm_phase(lds, g, S, E); SEAM(6); }
    if (IN(7)) { const Params p = load_params(); pg8::Gemm g{(const bf16_t*)(p.ws + WS_AB) + (size_t)NTOK * 512, (const bf16_t*)(p.ws + WS_WPAB) + (size_t)D * 512, 512}; pg8::StaticOrder S{NTOK / 256, 4, G, c};
        pg8::EpiY<false> E{(bf16_t*)(p.ws + WS_Y), (const bf16_t*)(p.ws + WS_P)}; pg8::gemm_phase(lds, g, S, E); SEAM(7); }
    if (IN(8)) { const Params p = load_params(); pg8::Gemm g{(const bf16_t*)(p.ws + WS_Y), (const bf16_t*)(p.ws + WS_WOUT), D}; pg8::StaticOrder S{NTOK / 256, 4, G, c};
        pg8::EpiF32 E{(float*)(p.ws + WS_YL), D}; pg8::gemm_phase(lds, g, S, E); SEAM(8); }
    if (IN(9)) { const Params p = load_params(); ph_post(p, lds); SEAM(9); }
    if (IN(10)) { const Params p = load_params(); ph_scatter(p, lds); SEAM(10); }
    if (IN(11)) { const Params p = load_params();
        LAS int* tab = (LAS int*)(lds + LDS_STAGE); const int* gtab = (const int*)(p.ws + WS_TAB);
        for (int i = threadIdx.x; i < 1 + MAXBLK; i += 512) tab[i] = gtab[i];
        __syncthreads();
        pg8::Gemm g{(const bf16_t*)(p.ws + WS_XB), (const bf16_t*)(p.ws + WS_WGU), D}; pg8::OrderMoe S{G, c, 8, tab};
        pg8::EpiAct E{(bf16_t*)(p.ws + WS_ACT), p.in[22]}; pg8::gemm_phase(lds, g, S, E); SEAM(11); }
    if (IN(12)) { const Params p = load_params();
        LAS int* tab = (LAS int*)(lds + LDS_STAGE); const int* gtab = (const int*)(p.ws + WS_TAB);
        for (int i = threadIdx.x; i < 1 + MAXBLK; i += 512) tab[i] = gtab[i];
        __syncthreads();
        pg8::Gemm g{(const bf16_t*)(p.ws + WS_ACT), (const bf16_t*)(p.ws + WS_WDN), D}; pg8::OrderMoe S{G, c, 4, tab};
        pg8::EpiDown E{(bf16_t*)(p.ws + WS_YB), p.in[24], (const float*)(p.ws + WS_PW)}; pg8::gemm_phase(lds, g, S, E); SEAM(12); }
    if (IN(13)) { const Params p = load_params(); ph_combine(p); }
#undef IN
#undef SEAM
}

#ifndef N_LAUNCH_MODE
#define N_LAUNCH_MODE 0
#endif

extern "C" void kernel_launch(void* const* d_in, const int* in_sizes, int n_in, void* d_out, int out_size, void* d_ws, size_t ws_size, hipStream_t stream) {
    static int grid_blocks = 0;
    if (grid_blocks == 0) {
        if (n_in != 25 || ws_size < WS_END) { fprintf(stderr, "kernel_launch: unexpected n_in %d or ws_size %zu (< %zu)\n", n_in, ws_size, (size_t)WS_END); grid_blocks = -1; return; }
        int dev = 0, cus = 0, per_cu = 0;
        hipGetDevice(&dev);
        hipDeviceGetAttribute(&cus, hipDeviceAttributeMultiprocessorCount, dev);
        hipFuncSetAttribute((const void*)mega_fwd, hipFuncAttributeMaxDynamicSharedMemorySize, LDS_BYTES);
        hipOccupancyMaxActiveBlocksPerMultiprocessor(&per_cu, (const void*)mega_fwd, 512, LDS_BYTES);
        if (per_cu < 1) { fprintf(stderr, "kernel_launch: occupancy query says %d blocks/CU\n", per_cu); per_cu = 1; }
        if (per_cu > 1) per_cu = 1;
        grid_blocks = cus * per_cu;
    }
    if (grid_blocks < 0) return;
    Params p{};
    for (int i = 0; i < 25; ++i) p.in[i] = (const float*)d_in[i];
    p.out = (float*)d_out; p.ws = (unsigned char*)d_ws;
#if N_LAUNCH_MODE == 1
    p.ph_lo = 0; p.ph_hi = NPHASE;
    { void* args[] = {&p}; hipError_t e = hipLaunchCooperativeKernel((const void*)mega_fwd, dim3(grid_blocks), dim3(512), args, LDS_BYTES, stream);
      if (e != hipSuccess) fprintf(stderr, "cooperative launch failed: %s (grid %d)\n", hipGetErrorString(e), grid_blocks); }
#else
    for (int ph = 0; ph < NPHASE; ++ph) {
        p.ph_lo = ph; p.ph_hi = ph + 1;
        void* args[] = {&p}; hipError_t e = hipLaunchCooperativeKernel((const void*)mega_fwd, dim3(grid_blocks), dim3(512), args, LDS_BYTES, stream);
        if (e != hipSuccess) { fprintf(stderr, "cooperative launch (phase %d) failed: %s (grid %d)\n", ph, hipGetErrorString(e), grid_blocks); break; }
    }
#endif
}
```

```cpp
#include <hip/hip_runtime.h>
#include <hip/hip_cooperative_groups.h>
#include <cstdio>
namespace cg = cooperative_groups;

#define LAS __attribute__((address_space(3)))
typedef unsigned short bf16_t;
typedef short bf16x8 __attribute__((ext_vector_type(8)));
typedef float f32x4 __attribute__((ext_vector_type(4)));
typedef float f32x2 __attribute__((ext_vector_type(2)));
typedef unsigned u32x4 __attribute__((ext_vector_type(4)));
typedef unsigned u32x2 __attribute__((ext_vector_type(2)));

constexpr int D = 1024, NB = 16, T = 2048, TC = 256;
constexpr int NTOK = NB * T, NCTX = NB * TC, MROWS = NTOK + NCTX;
constexpr int NIN = 6672, NP = 6656;
constexpr int C_MQ = 0, C_MK = 512, C_MV = 1024, C_MO = 1536, C_HQ = 2048, C_HI = 2560, C_HG = 3072, C_HF = 3584, C_GA = 4608, C_GB = 5632, C_MG = 6656;
constexpr int NE = 32, TOPK = 4, PMAX = NTOK * TOPK + NE * 256, MAXBLK = PMAX / 256;
constexpr float EPS = 1e-6f;
constexpr int NPHASE = 14;
constexpr int LDS_STAGE = 131072, LDS_BYTES = LDS_STAGE + 16384;

constexpr size_t al256(size_t x) { return (x + 255) & ~(size_t)255; }
constexpr size_t SZ_T = (size_t)NB * 4 * 128 * 2304 * 2;
constexpr size_t SZ_N = (size_t)NTOK * 512 * 2;
constexpr size_t SZ_ST = (size_t)NB * 4 * 2 * 32 * 128 * 128 * 2;
constexpr int PD_W = 3584, PL_W = 3072;
constexpr int PD_MQ = 0, PD_MK = 512, PD_MV = 1024, PD_HQ = 1536, PD_HI = 2048, PD_HF = 2560;
constexpr int PL_MO = 0, PL_HG = 512, PL_GA = 1024, PL_GB = 2048;
constexpr int NBHD = NB * 4 * 2;
constexpr size_t WS_WIN = 0;
constexpr size_t WS_WPAB = WS_WIN + (size_t)NP * D * 2;
constexpr size_t WS_WOUT = WS_WPAB + (size_t)D * D * 2;
constexpr size_t WS_MOD = WS_WOUT + (size_t)D * D * 2;
constexpr size_t WS_MG = al256(WS_MOD + 17 * 6144 * 4);
constexpr size_t WS_TOPE = al256(WS_MG + (size_t)MROWS * 16 * 4);
constexpr size_t WS_TOPW = WS_TOPE + (size_t)NTOK * 4 * 4;
constexpr size_t WS_DEST = WS_TOPW + (size_t)NTOK * 4 * 4;
constexpr size_t WS_PW = WS_DEST + (size_t)NTOK * 4 * 4;
constexpr size_t WS_PTOK = al256(WS_PW + (size_t)PMAX * 4);
constexpr size_t WS_CNT = al256(WS_PTOK + (size_t)PMAX * 4);
constexpr size_t WS_TAB = WS_CNT + 256 * 32 * 4;
constexpr size_t WS_BAR = WS_TAB + 4096;
constexpr size_t WS_GW = WS_BAR + 16384;
constexpr size_t WS_G1 = WS_GW + (size_t)NBHD * 2304 * 4;
constexpr size_t WS_WB = WS_G1 + (size_t)NBHD * 2304 * 4;
constexpr size_t WS_DEC = WS_WB + (size_t)NBHD * 2304 * 2;
constexpr size_t WS_EAL = al256(WS_DEC + (size_t)NBHD * 36 * 4);
constexpr size_t WS_NS = WS_EAL + (size_t)NBHD * 36 * 128 * 4;
constexpr size_t WS_HL = al256(WS_NS + (size_t)NBHD * 32 * 128 * 4);
constexpr size_t WS_QK = WS_HL;
constexpr size_t WS_RW = WS_HL + (size_t)MROWS * D * 2;
constexpr size_t WS_WGU = WS_RW;
constexpr size_t WS_WDN = WS_WGU + (size_t)NE * 2048 * D * 2;
constexpr size_t WS_KEFN = WS_RW, WS_KEBN = WS_RW + SZ_N, WS_QPFN = WS_RW + 2 * SZ_N, WS_QPBN = WS_RW + 3 * SZ_N;
constexpr size_t WS_AB = WS_RW + 4 * SZ_N;
constexpr size_t WS_RPD = WS_WDN + (size_t)NE * D * D * 2;
constexpr size_t WS_PD = WS_RPD;
constexpr size_t WS_HS = WS_RPD;
constexpr size_t WS_YL = WS_RPD;
constexpr size_t WS_RT = WS_RPD + 2 * SZ_ST;
constexpr size_t WS_KT = WS_RT, WS_VTF = WS_RT + SZ_T, WS_VTB = WS_RT + 2 * SZ_T, WS_KEFT = WS_RT + 3 * SZ_T, WS_KEBT = WS_RT + 4 * SZ_T, WS_IT = WS_RT + 5 * SZ_T;
constexpr size_t WS_Y = WS_RT;
constexpr size_t WS_RPL = WS_RT + 6 * SZ_T;
constexpr size_t WS_PL = WS_RPL;
constexpr size_t WS_XB = WS_RPD;
constexpr size_t WS_ACT = WS_XB + (size_t)PMAX * D * 2;
constexpr size_t WS_YB = WS_XB;
constexpr size_t WS_X1B = WS_ACT + (size_t)PMAX * D * 2;
constexpr size_t WS_END1 = WS_RPL + (size_t)NTOK * PL_W * 2;
constexpr size_t WS_END2 = WS_X1B + (size_t)NTOK * D * 2;
constexpr size_t WS_END = WS_END1 > WS_END2 ? WS_END1 : WS_END2;
static_assert((size_t)MROWS * PD_W * 2 <= 2 * SZ_ST, "P_dead must fit its region");
static_assert(WS_AB + (size_t)NTOK * D * 2 <= WS_RPD, "AB must fit the expert-weight region");
static_assert(WS_END <= (size_t)4 * 268435456, "workspace too large");

struct Params { const float* in[25]; float* out; unsigned char* ws; int ph_lo, ph_hi; };

__device__ __forceinline__ int otid() { int t = threadIdx.x; asm volatile("" : "+v"(t)); return t; }
__device__ __forceinline__ unsigned cvt_pk_bf16(float lo, float hi) { unsigned r; asm volatile("v_cvt_pk_bf16_f32 %0, %1, %2" : "=v"(r) : "v"(lo), "v"(hi)); return r; }
__device__ __forceinline__ float bf_lo(unsigned w) { return __uint_as_float(w << 16); }
__device__ __forceinline__ float bf_hi(unsigned w) { return __uint_as_float(w & 0xffff0000u); }
__device__ __forceinline__ float sigmoidf_(float x) { return __builtin_amdgcn_rcpf(1.0f + __builtin_amdgcn_exp2f(-1.4426950408889634f * x)); }
__device__ __forceinline__ float siluf_(float x) { return x * __builtin_amdgcn_rcpf(1.0f + __builtin_amdgcn_exp2f(-1.4426950408889634f * x)); }
__device__ __forceinline__ float wave_sum(float v) {
#pragma unroll
    for (int o = 1; o < 64; o <<= 1) v += __shfl_xor(v, o);
    return v;
}
__device__ __forceinline__ void unpack8(const u32x4 w, float (&f)[8]) {
    f[0] = bf_lo(w.x); f[1] = bf_hi(w.x); f[2] = bf_lo(w.y); f[3] = bf_hi(w.y); f[4] = bf_lo(w.z); f[5] = bf_hi(w.z); f[6] = bf_lo(w.w); f[7] = bf_hi(w.w);
}
__device__ __forceinline__ u32x4 pack8(const float (&f)[8]) {
    u32x4 w; w.x = cvt_pk_bf16(f[0], f[1]); w.y = cvt_pk_bf16(f[2], f[3]); w.z = cvt_pk_bf16(f[4], f[5]); w.w = cvt_pk_bf16(f[6], f[7]); return w;
}

namespace pg8 {
constexpr int BM = 256, BK = 64, HALF = 128, HTB = HALF * BK * 2, STAGE_BYTES = 8 * HTB, NXCD = 8, WGM = 8;
__device__ __forceinline__ int lds_byte(int r, int c) { const int st = (r >> 4) * 2 + (c >> 5), rr = r & 15, cc = c & 31, ob = rr * 64 + cc * 2; return st * 1024 + (ob ^ (((ob >> 9) & 1) << 5)); }
__device__ __forceinline__ void stage_rc(int b, int& R, int& C) { const int st = b / 1024, sb = b % 1024, swz = sb ^ (((sb >> 9) & 1) << 5); R = (st >> 1) * 16 + swz / 64; C = (st & 1) * 32 + (swz % 64) / 2; }
__device__ __forceinline__ int perm32(int rho) { const int n = rho >> 4, i = rho & 15; return 8 * (i >> 2) + 4 * n + (i & 3); }

struct Unit { int pm, pn, pb, e, pa; };
struct Gemm { const bf16_t* A; const bf16_t* Bt; int K; };

__device__ __forceinline__ void static_map(int wgid, int nM, int nN, int& pm, int& pn) {
    const int nwg = nM * nN;
    { const int q = nwg / NXCD, r = nwg % NXCD, xcd = wgid % NXCD, off = wgid / NXCD; wgid = (xcd < r ? xcd * (q + 1) : r * (q + 1) + (xcd - r) * q) + off; }
    const int nig = WGM * nN, gid = wgid / nig, fm = gid * WGM, gsz = (nM - fm) < WGM ? (nM - fm) : WGM;
    pm = fm + ((wgid % nig) % gsz); pn = (wgid % nig) / gsz;
}
struct StaticOrder {
    static constexpr bool GATHER = false;
    int nM, nN, G, c;
    __device__ __forceinline__ bool next(int i, Unit& u) const {
        const int L = i * G + c; if (L >= nM * nN) return false;
        static_map(L, nM, nN, u.pm, u.pn); u.pb = u.pn; u.e = 0; u.pa = u.pm; return true;
    }
};
struct OrderP {
    static constexpr bool GATHER = false;
    int G, c;
    __device__ __forceinline__ bool next(int i, Unit& u) const {
        const int L = i * G + c;
        if (L < 128 * 26) { static_map(L, 128, 26, u.pm, u.pn); }
        else { const int r = L - 128 * 26; if (r >= 160) return false; const int q = r >> 4; u.pm = 128 + (r & 15); u.pn = q < 4 ? 2 + q : (q < 6 ? 6 + q : 8 + q); }
        u.pb = u.pn; u.e = 0; u.pa = u.pm; return true;
    }
};
struct OrderY {
    static constexpr bool GATHER = false;
    int G, c;
    __device__ __forceinline__ bool next(int i, Unit& u) const {
        const int L = (i >> 1) * G + c, which = i & 1; if (L >= (NTOK / 256) * 4) return false;
        static_map(L, NTOK / 256, 4, u.pm, u.pn); u.pa = u.pm + which * (NTOK / 256); u.pb = u.pn + which * 4; u.e = which; return true;
    }
};
template <bool GATHER_> struct OrderMoe {
    static constexpr bool GATHER = GATHER_;
    int G, c, nN; const LAS int* tab; const int* rowidx;
    __device__ __forceinline__ bool next(int i, Unit& u) const {
        int pm, pn;
        if ((G & 7) == 0 && G >= 64) { const int ppx = (G >> 3) / nN, j = c >> 3; pm = i * (8 * ppx) + (c & 7) * ppx + j / nN; pn = j % nN; }
        else { const int L = i * G + c; pm = L / nN; pn = L - pm * nN; }
        const int nblk = __builtin_amdgcn_readfirstlane(tab[0]);
        if (pm >= nblk) return false;
        const int e = __builtin_amdgcn_readfirstlane(tab[1 + pm]);
        u.pm = pm; u.pn = pn; u.pb = e * nN + pn; u.e = e; u.pa = pm; return true;
    }
};

template <class Epi, class Sched>
__device__ __forceinline__ void gemm_phase(LAS unsigned char* lds, const Gemm g, const Sched& S, const Epi& E) {
    const int tid = otid(), wid = __builtin_amdgcn_readfirstlane(tid >> 6), lane = tid & 63, wr = wid >> 2, wc = wid & 3, fr = lane & 15, fq = lane >> 4;
    const int K = g.K, nt = K / BK;
    unsigned voffB[2], vc[2][2], vn[2][2]; int Ra[2], Cb[2];
#pragma unroll
    for (int i = 0; i < 2; ++i) { int R, C; stage_rc(tid * 16 + i * 8192, R, C); const int Rb = Epi::PERM ? ((R & ~31) + perm32(R & 31)) : R;
        Ra[i] = R; Cb[i] = C * 2; voffB[i] = (unsigned)(Rb * K + C) * 2u; vc[0][i] = vc[1][i] = vn[0][i] = vn[1][i] = (unsigned)(R * K + C) * 2u; }
    LAS int* gidx = (LAS int*)(lds + STAGE_BYTES + 4096);
    LAS unsigned char* ebase = lds + STAGE_BYTES + 6144;
    const size_t kstep = (size_t)(BK * 2);
    const size_t hstep = (size_t)HALF * K * 2;
    const size_t tstep = 2 * hstep;
    const size_t hsA = Sched::GATHER ? 0 : hstep;
    const unsigned ldsw = (unsigned)wid * 1024u;
    const int aoff = lds_byte(wr * 64 + fr, fq * 8), boff = lds_byte(wc * 32 + fr, fq * 8);
#define PG8_SA(b, h) (((b) * 2 + (h)) * HTB)
#define PG8_SB(b, h) ((4 + (b) * 2 + (h)) * HTB)
#define PG8_STAGE(bufoff, gbase, voff) do { _Pragma("unroll") for (int _i = 0; _i < 2; ++_i) \
        __builtin_amdgcn_global_load_lds((const unsigned*)((const char*)(gbase) + (voff)[_i]), (LAS unsigned*)(lds + (bufoff) + ldsw + _i * 8192), 16, 0, 0); } while (0)
#define PG8_LDA(dst, b, h) do { _Pragma("unroll") for (int m = 0; m < 4; ++m) _Pragma("unroll") for (int k = 0; k < 2; ++k) dst[m][k] = *(const LAS bf16x8*)(lds + PG8_SA(b, h) + aoff + m * 2048 + k * 1024); } while (0)
#define PG8_LDB(dst, b, h) do { _Pragma("unroll") for (int n = 0; n < 2; ++n) _Pragma("unroll") for (int k = 0; k < 2; ++k) dst[n][k] = *(const LAS bf16x8*)(lds + PG8_SB(b, h) + boff + n * 2048 + k * 1024); } while (0)
#define PG8_MMA(ai, bj, At, Bt) do { __builtin_amdgcn_s_setprio(1); _Pragma("unroll") for (int m = 0; m < 4; ++m) _Pragma("unroll") for (int n = 0; n < 2; ++n) _Pragma("unroll") for (int k = 0; k < 2; ++k) \
        acc[ai][bj][m][n] = __builtin_amdgcn_mfma_f32_16x16x32_bf16(Bt[n][k], At[m][k], acc[ai][bj][m][n], 0, 0, 0); __builtin_amdgcn_s_setprio(0); } while (0)
#define PG8_WAIT_V(n) asm volatile("s_waitcnt vmcnt(" #n ")" ::: "memory")
#define PG8_WAIT_L(n) asm volatile("s_waitcnt lgkmcnt(" #n ")" ::: "memory")
#define PG8_BAR __builtin_amdgcn_s_barrier()
#define PG8_SCHED __builtin_amdgcn_sched_barrier(0)
    Unit cur, nxt; int ui = 0;
    if (!S.next(0, cur)) return;
    f32x4 acc[2][2][4][2];
#pragma unroll
    for (int a = 0; a < 2; ++a)
#pragma unroll
        for (int b = 0; b < 2; ++b)
#pragma unroll
            for (int m = 0; m < 4; ++m)
#pragma unroll
                for (int n = 0; n < 2; ++n) acc[a][b][m][n] = (f32x4){0.f, 0.f, 0.f, 0.f};
    bf16x8 At[4][2], B0[2][2], B1[2][2];
    const char* cA = Sched::GATHER ? (const char*)g.A : (const char*)g.A + (size_t)cur.pa * tstep; const char* cB = (const char*)g.Bt + (size_t)cur.pb * tstep;
    if constexpr (Sched::GATHER) {
        if (wid == 0) __builtin_amdgcn_global_load_lds((const unsigned*)(S.rowidx + (size_t)cur.pm * 256 + 4 * lane), (LAS unsigned*)gidx, 16, 0, 0);
        asm volatile("s_waitcnt vmcnt(0)" ::: "memory"); __syncthreads();
#pragma unroll
        for (int h = 0; h < 2; ++h)
#pragma unroll
            for (int i = 0; i < 2; ++i) { vc[h][i] = (unsigned)gidx[h * 128 + Ra[i]] * (unsigned)(K * 2) + (unsigned)Cb[i]; vn[h][i] = vc[h][i]; }
    }
    PG8_STAGE(PG8_SB(0, 0), cB, voffB); PG8_STAGE(PG8_SA(0, 0), cA, vc[0]); PG8_STAGE(PG8_SB(0, 1), cB + hstep, voffB); PG8_STAGE(PG8_SA(0, 1), cA + hsA, vc[1]);
    if (wr == 1) PG8_BAR;
    PG8_WAIT_V(4); PG8_BAR;
    PG8_STAGE(PG8_SB(1, 0), cB + kstep, voffB); PG8_STAGE(PG8_SA(1, 0), cA + kstep, vc[0]); PG8_STAGE(PG8_SB(1, 1), cB + hstep + kstep, voffB);
    PG8_WAIT_V(6); PG8_BAR;
    for (;;) {
        const bool has_next = S.next(ui + 1, nxt);
        E.prefetch(cur, ebase + (ui & 1) * 3072, wid, lane);
        const char* nA = Sched::GATHER ? cA : (has_next ? (const char*)g.A + (size_t)nxt.pa * tstep : cA); const char* nB = has_next ? (const char*)g.Bt + (size_t)nxt.pb * tstep : cB;
        if constexpr (Sched::GATHER) { if (has_next && wid == 0) __builtin_amdgcn_global_load_lds((const unsigned*)(S.rowidx + (size_t)nxt.pm * 256 + 4 * lane), (LAS unsigned*)(gidx + ((ui + 1) & 1) * 256), 16, 0, 0); }
        for (int t = 0; t < nt; t += 2) {
            const bool last = (t == nt - 2);
            const char* a1 = cA + (size_t)(t + 1) * kstep;
            const char* a2 = last ? nA : cA + (size_t)(t + 2) * kstep; const char* b2 = last ? nB : cB + (size_t)(t + 2) * kstep;
            const char* a3 = a2 + kstep; const char* b3 = b2 + kstep;
            if constexpr (Sched::GATHER) { if (last && has_next) {
#pragma unroll
                for (int h = 0; h < 2; ++h)
#pragma unroll
                    for (int i = 0; i < 2; ++i) vn[h][i] = (unsigned)gidx[((ui + 1) & 1) * 256 + h * 128 + Ra[i]] * (unsigned)(K * 2) + (unsigned)Cb[i]; } }
            unsigned w2[2][2];
#pragma unroll
            for (int h = 0; h < 2; ++h)
#pragma unroll
                for (int i = 0; i < 2; ++i) w2[h][i] = last ? vn[h][i] : vc[h][i];
            PG8_LDB(B0, 0, 0); PG8_SCHED; PG8_LDA(At, 0, 0); PG8_STAGE(PG8_SA(1, 1), a1 + hsA, vc[1]);
            PG8_WAIT_L(8); PG8_BAR; PG8_WAIT_L(0); PG8_MMA(0, 0, At, B0); PG8_BAR; PG8_SCHED;
            PG8_LDB(B1, 0, 1); PG8_STAGE(PG8_SB(0, 0), b2, voffB);
            PG8_BAR; PG8_WAIT_L(0); PG8_MMA(0, 1, At, B1); PG8_BAR;
            PG8_LDA(At, 0, 1); PG8_STAGE(PG8_SA(0, 0), a2, w2[0]);
            PG8_BAR; PG8_WAIT_L(0); PG8_MMA(1, 0, At, B0); PG8_BAR; PG8_SCHED;
            PG8_STAGE(PG8_SB(0, 1), b2 + hstep, voffB);
            PG8_WAIT_V(6); PG8_BAR; PG8_MMA(1, 1, At, B1); PG8_BAR;
            PG8_LDB(B0, 1, 0); PG8_SCHED; PG8_LDA(At, 1, 0); PG8_STAGE(PG8_SA(0, 1), a2 + hsA, w2[1]);
            PG8_WAIT_L(8); PG8_BAR; PG8_WAIT_L(0); PG8_MMA(0, 0, At, B0); PG8_BAR; PG8_SCHED;
            PG8_LDB(B1, 1, 1); PG8_STAGE(PG8_SB(1, 0), b3, voffB);
            PG8_BAR; PG8_WAIT_L(0); PG8_MMA(0, 1, At, B1); PG8_BAR;
            PG8_LDA(At, 1, 1); PG8_STAGE(PG8_SA(1, 0), a3, w2[0]);
            PG8_BAR; PG8_WAIT_L(0); PG8_MMA(1, 0, At, B0); PG8_BAR; PG8_SCHED;
            PG8_STAGE(PG8_SB(1, 1), b3 + hstep, voffB);
            PG8_WAIT_V(6); PG8_BAR; PG8_MMA(1, 1, At, B1); PG8_BAR;
        }
        bool carry = false;
        if constexpr (Epi::CARRY) { carry = E.first_pass(cur); if (carry) E.rescale(acc, cur, wr, wc, fr, fq); }
        if (!carry) E(acc, cur, wr, wc, fr, fq, ebase + (ui & 1) * 3072);
        if (!has_next) break;
        if (!carry) {
#pragma unroll
        for (int a = 0; a < 2; ++a)
#pragma unroll
            for (int b = 0; b < 2; ++b)
#pragma unroll
                for (int m = 0; m < 4; ++m)
#pragma unroll
                    for (int n = 0; n < 2; ++n) acc[a][b][m][n] = (f32x4){0.f, 0.f, 0.f, 0.f};
        }
        cur = nxt; cA = nA; cB = nB; ++ui;
#pragma unroll
        for (int h = 0; h < 2; ++h)
#pragma unroll
            for (int i = 0; i < 2; ++i) vc[h][i] = vn[h][i];
    }
    PG8_WAIT_V(0);
    if (wr == 0) PG8_BAR;
    PG8_BAR;
#undef PG8_SA
#undef PG8_SB
#undef PG8_STAGE
#undef PG8_LDA
#undef PG8_LDB
#undef PG8_MMA
#undef PG8_WAIT_V
#undef PG8_WAIT_L
#undef PG8_BAR
#undef PG8_SCHED
}

struct EpiF32 {
    static constexpr bool PERM = false, MID = false, CARRY = false;
    float* C; int ldc;
    __device__ __forceinline__ void prefetch(const Unit&, LAS unsigned char*, int, int) const {}
    __device__ __forceinline__ void operator()(const f32x4 (&acc)[2][2][4][2], const Unit& u, int wr, int wc, int fr, int fq, const LAS unsigned char*) const {
        const int row0 = u.pm * BM + wr * 64 + fr, col0 = u.pn * BM + wc * 32 + 4 * fq;
#pragma unroll
        for (int ai = 0; ai < 2; ++ai)
#pragma unroll
            for (int m = 0; m < 4; ++m) { float* rowp = C + (size_t)(row0 + ai * HALF + m * 16) * ldc + col0;
#pragma unroll
                for (int bj = 0; bj < 2; ++bj)
#pragma unroll
                    for (int n = 0; n < 2; ++n) *(f32x4*)(rowp + bj * HALF + n * 16) = acc[ai][bj][m][n]; }
    }
};
struct EpiBf {
    static constexpr bool PERM = true, MID = false, CARRY = false;
    bf16_t* C; int ldc;
    __device__ __forceinline__ void prefetch(const Unit&, LAS unsigned char*, int, int) const {}
    __device__ __forceinline__ void operator()(const f32x4 (&acc)[2][2][4][2], const Unit& u, int wr, int wc, int fr, int fq, const LAS unsigned char*) const {
        const int row0 = u.pm * BM + wr * 64 + fr, col0 = u.pn * BM + wc * 32 + 8 * fq;
#pragma unroll
        for (int ai = 0; ai < 2; ++ai)
#pragma unroll
            for (int m = 0; m < 4; ++m) { bf16_t* rowp = C + (size_t)(row0 + ai * HALF + m * 16) * ldc + col0;
#pragma unroll
                for (int bj = 0; bj < 2; ++bj) { const f32x4 v0 = acc[ai][bj][m][0], v1 = acc[ai][bj][m][1];
                    u32x4 w; w.x = cvt_pk_bf16(v0[0], v0[1]); w.y = cvt_pk_bf16(v0[2], v0[3]); w.z = cvt_pk_bf16(v1[0], v1[1]); w.w = cvt_pk_bf16(v1[2], v1[3]);
                    *(u32x4*)(rowp + bj * HALF) = w; } }
    }
};
struct EpiP {
    static constexpr bool PERM = true, MID = false, CARRY = false;
    bf16_t* PD; bf16_t* PL; const float* b_in; const float* lb_raw;
    __device__ __forceinline__ void prefetch(const Unit& u, LAS unsigned char* eb, int wid, int lane) const {
        if (wid == 0) __builtin_amdgcn_global_load_lds((const unsigned*)(b_in + u.pn * 256 + 4 * lane), (LAS unsigned*)eb, 16, 0, 0);
        if (u.pn >= 14 && u.pn < 18 && (wid == 1 || wid == 2))
            __builtin_amdgcn_global_load_lds((const unsigned*)(lb_raw + (wid - 1) * 1024 + (u.pn * 256 - C_HF) + 4 * lane), (LAS unsigned*)(eb + wid * 1024), 16, 0, 0);
    }
    __device__ __forceinline__ void operator()(const f32x4 (&acc)[2][2][4][2], const Unit& u, int wr, int wc, int fr, int fq, const LAS unsigned char* eb) const {
        const int pn = u.pn;
        bf16_t* base; int ldw, dcol;
        if (pn < 6) { base = PD; ldw = PD_W; dcol = pn * 256; }
        else if (pn < 8) { base = PL; ldw = PL_W; dcol = PL_MO + (pn - 6) * 256; }
        else if (pn < 12) { base = PD; ldw = PD_W; dcol = PD_HQ + (pn - 8) * 256; }
        else if (pn < 14) { base = PL; ldw = PL_W; dcol = PL_HG + (pn - 12) * 256; }
        else if (pn < 18) { base = PD; ldw = PD_W; dcol = PD_HF + (pn - 14) * 256; }
        else { base = PL; ldw = PL_W; dcol = PL_GA + (pn - 18) * 256; }
        const int row0 = u.pm * BM + wr * 64 + fr, col0 = pn * BM + wc * 32 + 8 * fq, ocol = dcol + wc * 32 + 8 * fq;
        const int kind = (pn >= 6 && pn < 8) ? 1 : ((pn >= 8 && pn < 10) || (pn >= 12 && pn < 14)) ? 2 : (pn >= 14 && pn < 18) ? 3 : (pn >= 18) ? 1 : 0;
        f32x4 bv[2][2], lbv[2][2];
#pragma unroll
        for (int bj = 0; bj < 2; ++bj)
#pragma unroll
            for (int n = 0; n < 2; ++n) {
                const int cl = (wc * 32 + 8 * fq + bj * HALF + 4 * n) * 4;
                bv[bj][n] = *(const LAS f32x4*)(eb + cl);
                lbv[bj][n] = (f32x4){0.f, 0.f, 0.f, 0.f};
                if (kind == 3) { const f32x4 r0 = *(const LAS f32x4*)(eb + 1024 + cl), r1 = *(const LAS f32x4*)(eb + 2048 + cl);
#pragma unroll
                    for (int j = 0; j < 4; ++j) lbv[bj][n][j] = 1.0f - 1.0f / (1.0f + __expf(r1[j] - r0[j])); }
            }
#pragma unroll
        for (int ai = 0; ai < 2; ++ai)
#pragma unroll
            for (int m = 0; m < 4; ++m) { bf16_t* rowp = base + (size_t)(row0 + ai * HALF + m * 16) * ldw + ocol;
#pragma unroll
                for (int bj = 0; bj < 2; ++bj) { f32x4 v0 = acc[ai][bj][m][0] + bv[bj][0], v1 = acc[ai][bj][m][1] + bv[bj][1];
                    if (kind == 1) {
#pragma unroll
                        for (int j = 0; j < 4; ++j) { v0[j] = sigmoidf_(v0[j]); v1[j] = sigmoidf_(v1[j]); } }
                    else if (kind == 2) {
#pragma unroll
                        for (int j = 0; j < 4; ++j) { v0[j] = siluf_(v0[j]); v1[j] = siluf_(v1[j]); } }
                    else if (kind == 3) {
#pragma unroll
                        for (int j = 0; j < 4; ++j) { v0[j] = lbv[bj][0][j] * __builtin_amdgcn_rcpf(1.0f + __builtin_amdgcn_exp2f(1.4426950408889634f * v0[j])); v1[j] = lbv[bj][1][j] * __builtin_amdgcn_rcpf(1.0f + __builtin_amdgcn_exp2f(1.4426950408889634f * v1[j])); } }
                    u32x4 w; w.x = cvt_pk_bf16(v0[0], v0[1]); w.y = cvt_pk_bf16(v0[2], v0[3]); w.z = cvt_pk_bf16(v1[0], v1[1]); w.w = cvt_pk_bf16(v1[2], v1[3]);
                    *(u32x4*)(rowp + bj * HALF) = w; } }
    }
};
struct EpiY {
    static constexpr bool PERM = true, MID = false, CARRY = true;
    bf16_t* Y; const bf16_t* P;
    __device__ __forceinline__ void prefetch(const Unit&, LAS unsigned char*, int, int) const {}
    __device__ __forceinline__ bool first_pass(const Unit& u) const { return u.e == 0; }
    __device__ __forceinline__ void rescale(f32x4 (&acc)[2][2][4][2], const Unit& u, int wr, int wc, int fr, int fq) const {
        const int row0 = u.pm * BM + wr * 64 + fr, col0 = u.pn * BM + wc * 32 + 8 * fq;
#pragma unroll
        for (int ai = 0; ai < 2; ++ai)
#pragma unroll
            for (int mh = 0; mh < 2; ++mh) {
                u32x4 ga[2][2], gb[2][2];
#pragma unroll
                for (int m2 = 0; m2 < 2; ++m2) { const size_t r = (size_t)(row0 + ai * HALF + (2 * mh + m2) * 16);
#pragma unroll
                    for (int bj = 0; bj < 2; ++bj) { ga[m2][bj] = *(const u32x4*)(P + r * PL_W + PL_GA + col0 + bj * HALF); gb[m2][bj] = *(const u32x4*)(P + r * PL_W + PL_GB + col0 + bj * HALF); } }
#pragma unroll
                for (int m2 = 0; m2 < 2; ++m2)
#pragma unroll
                    for (int bj = 0; bj < 2; ++bj) { float a[8], b[8]; unpack8(ga[m2][bj], a); unpack8(gb[m2][bj], b);
#pragma unroll
                        for (int j = 0; j < 4; ++j) { acc[ai][bj][2 * mh + m2][0][j] *= a[j] * __builtin_amdgcn_rcpf(b[j]); acc[ai][bj][2 * mh + m2][1][j] *= a[4 + j] * __builtin_amdgcn_rcpf(b[4 + j]); } }
                asm volatile("" ::: "memory");
            }
    }
    __device__ __forceinline__ void operator()(const f32x4 (&acc)[2][2][4][2], const Unit& u, int wr, int wc, int fr, int fq, const LAS unsigned char*) const {
        const int row0 = u.pm * BM + wr * 64 + fr, col0 = u.pn * BM + wc * 32 + 8 * fq;
#pragma unroll
        for (int ai = 0; ai < 2; ++ai) {
            u32x4 gg[4][2];
#pragma unroll
            for (int m = 0; m < 4; ++m) { const size_t r = (size_t)(row0 + ai * HALF + m * 16);
#pragma unroll
                for (int bj = 0; bj < 2; ++bj) gg[m][bj] = *(const u32x4*)(P + r * PL_W + PL_GB + col0 + bj * HALF); }
#pragma unroll
            for (int m = 0; m < 4; ++m) { const size_t r = (size_t)(row0 + ai * HALF + m * 16);
#pragma unroll
                for (int bj = 0; bj < 2; ++bj) { float b[8], o[8]; unpack8(gg[m][bj], b); const f32x4 v0 = acc[ai][bj][m][0], v1 = acc[ai][bj][m][1];
#pragma unroll
                    for (int j = 0; j < 4; ++j) { o[j] = v0[j] * b[j]; o[4 + j] = v1[j] * b[4 + j]; }
                    *(u32x4*)(Y + r * D + col0 + bj * HALF) = pack8(o); } }
            asm volatile("" ::: "memory");
        }
    }
};
struct EpiAct {
    static constexpr bool PERM = true, MID = false, CARRY = false;
    bf16_t* ACT; const float* b_gu;
    __device__ __forceinline__ void prefetch(const Unit& u, LAS unsigned char* eb, int wid, int lane) const {
        if (wid == 0) __builtin_amdgcn_global_load_lds((const unsigned*)(b_gu + (size_t)u.e * 2048 + (lane >> 5) * 1024 + u.pn * 128 + 4 * (lane & 31)), (LAS unsigned*)eb, 16, 0, 0);
    }
    __device__ __forceinline__ void operator()(const f32x4 (&acc)[2][2][4][2], const Unit& u, int wr, int wc, int fr, int fq, const LAS unsigned char* eb) const {
        const int row0 = u.pm * BM + wr * 64 + fr, col0 = u.pn * HALF + wc * 32 + 8 * fq;
        const LAS unsigned char* bg = eb + (wc * 32 + 8 * fq) * 4;
        const f32x4 bg0 = *(const LAS f32x4*)(bg), bg1 = *(const LAS f32x4*)(bg + 16), bu0 = *(const LAS f32x4*)(bg + 512), bu1 = *(const LAS f32x4*)(bg + 528);
#pragma unroll
        for (int ai = 0; ai < 2; ++ai)
#pragma unroll
            for (int m = 0; m < 4; ++m) {
                const f32x4 g0 = acc[ai][0][m][0] + bg0, g1 = acc[ai][0][m][1] + bg1, u0 = acc[ai][1][m][0] + bu0, u1 = acc[ai][1][m][1] + bu1;
                float o[8];
#pragma unroll
                for (int j = 0; j < 4; ++j) {
                    { const float g = fminf(g0[j], 7.0f), up = fminf(fmaxf(u0[j], -7.0f), 7.0f); o[j] = (up + 1.0f) * g * __builtin_amdgcn_rcpf(1.0f + __builtin_amdgcn_exp2f(-2.4554669595930156f * g)); }
                    { const float g = fminf(g1[j], 7.0f), up = fminf(fmaxf(u1[j], -7.0f), 7.0f); o[4 + j] = (up + 1.0f) * g * __builtin_amdgcn_rcpf(1.0f + __builtin_amdgcn_exp2f(-2.4554669595930156f * g)); } }
                *(u32x4*)(ACT + (size_t)(row0 + ai * HALF + m * 16) * D + col0) = pack8(o); }
    }
};
struct EpiDown {
    static constexpr bool PERM = true, MID = false, CARRY = false;
    bf16_t* YB; const float* b_dn; const float* pw;
    __device__ __forceinline__ void prefetch(const Unit& u, LAS unsigned char* eb, int wid, int lane) const {
        if (wid == 0) __builtin_amdgcn_global_load_lds((const unsigned*)(b_dn + (size_t)u.e * D + u.pn * 256 + 4 * lane), (LAS unsigned*)eb, 16, 0, 0);
        if (wid == 1) __builtin_amdgcn_global_load_lds((const unsigned*)(pw + (size_t)u.pm * 256 + 4 * lane), (LAS unsigned*)(eb + 1024), 16, 0, 0);
    }
    __device__ __forceinline__ void operator()(const f32x4 (&acc)[2][2][4][2], const Unit& u, int wr, int wc, int fr, int fq, const LAS unsigned char* eb) const {
        const int row0 = u.pm * BM + wr * 64 + fr, col0 = u.pn * BM + wc * 32 + 8 * fq;
        f32x4 bv[2][2];
#pragma unroll
        for (int bj = 0; bj < 2; ++bj)
#pragma unroll
            for (int n = 0; n < 2; ++n) bv[bj][n] = *(const LAS f32x4*)(eb + (wc * 32 + 8 * fq + bj * HALF + 4 * n) * 4);
#pragma unroll
        for (int ai = 0; ai < 2; ++ai)
#pragma unroll
            for (int m = 0; m < 4; ++m) { const size_t r = (size_t)(row0 + ai * HALF + m * 16); const float w = *(const LAS float*)(eb + 1024 + (wr * 64 + fr + ai * HALF + m * 16) * 4);
#pragma unroll
                for (int bj = 0; bj < 2; ++bj) { const f32x4 v0 = (acc[ai][bj][m][0] + bv[bj][0]) * w, v1 = (acc[ai][bj][m][1] + bv[bj][1]) * w;
                    u32x4 o; o.x = cvt_pk_bf16(v0[0], v0[1]); o.y = cvt_pk_bf16(v0[2], v0[3]); o.z = cvt_pk_bf16(v1[0], v1[1]); o.w = cvt_pk_bf16(v1[2], v1[3]);
                    *(u32x4*)(YB + r * D + col0 + bj * HALF) = o; } }
    }
};
}

struct WItem { const float* src; bf16_t* dst; int ld, ldd; };
__device__ __forceinline__ void witem_load(const WItem& w, f32x4 (&v)[16], int lane) {
#pragma unroll
    for (int i = 0; i < 16; ++i) v[i] = __builtin_nontemporal_load((const f32x4*)(w.src + (size_t)(8 * i + (lane >> 3)) * w.ld + (lane & 7) * 4));
}
__device__ __forceinline__ void witem_finish(const WItem& w, const f32x4 (&v)[16], LAS float* scr, int lane) {
#pragma unroll
    for (int i = 0; i < 16; ++i) { LAS float* d = scr + (8 * i + (lane >> 3)) * 33 + (lane & 7) * 4; d[0] = v[i][0]; d[1] = v[i][1]; d[2] = v[i][2]; d[3] = v[i][3]; }
    asm volatile("s_waitcnt lgkmcnt(0)" ::: "memory");
    const int c = lane & 15;
#pragma unroll
    for (int j = 0; j < 8; ++j) { const int n = (lane >> 4) + 4 * j; const LAS float* s = scr + (8 * c) * 33 + n;
        u32x4 o; o.x = cvt_pk_bf16(s[0 * 33], s[1 * 33]); o.y = cvt_pk_bf16(s[2 * 33], s[3 * 33]); o.z = cvt_pk_bf16(s[4 * 33], s[5 * 33]); o.w = cvt_pk_bf16(s[6 * 33], s[7 * 33]);
        *(u32x4*)(w.dst + (size_t)n * w.ldd + 8 * c) = o; }
    asm volatile("s_waitcnt lgkmcnt(0)" ::: "memory");
}
__device__ __forceinline__ WItem witem_setup(const Params& p, int r) {
    constexpr int I_IN = 8 * 208, I_PA = 4 * 32;
    WItem w;
    if (r < I_IN) { const int kb = r / 208, nb = r % 208; w.src = p.in[10] + (size_t)(128 * kb) * NIN + 32 * nb; w.ld = NIN; w.dst = (bf16_t*)(p.ws + WS_WIN) + (size_t)(32 * nb) * D + 128 * kb; w.ldd = D; return w; } r -= I_IN;
    if (r < I_PA) { const int kb = r / 32, nb = r % 32; w.src = p.in[16] + (size_t)(128 * kb) * D + 32 * nb; w.ld = D; w.dst = (bf16_t*)(p.ws + WS_WPAB) + (size_t)(32 * nb) * 512 + 128 * kb; w.ldd = 512; return w; } r -= I_PA;
    if (r < I_PA) { const int kb = r / 32, nb = r % 32; w.src = p.in[17] + (size_t)(128 * kb) * D + 32 * nb; w.ld = D; w.dst = (bf16_t*)(p.ws + WS_WPAB) + (size_t)D * 512 + (size_t)(32 * nb) * 512 + 128 * kb; w.ldd = 512; return w; } r -= I_PA;
    { const int kb = r / 32, nb = r % 32; w.src = p.in[18] + (size_t)(128 * kb) * D + 32 * nb; w.ld = D; w.dst = (bf16_t*)(p.ws + WS_WOUT) + (size_t)(32 * nb) * D + 128 * kb; w.ldd = D; return w; }
}
__device__ __forceinline__ WItem witem_exp(const Params& p, int r) {
    constexpr int I_GU = NE * 8 * 64;
    WItem w; w.ldd = D;
    if (r < I_GU) { const int e = r / 512, q = r % 512, kb = q / 64, nb = q % 64, n0 = 32 * nb, jj = n0 & 1023, half = n0 >> 10, row0 = (jj >> 7) * 256 + half * 128 + (jj & 127);
        w.src = p.in[21] + (size_t)e * D * 2048 + (size_t)(128 * kb) * 2048 + n0; w.ld = 2048; w.dst = (bf16_t*)(p.ws + WS_WGU) + ((size_t)e * 2048 + row0) * D + 128 * kb; return w; } r -= I_GU;
    { const int e = r / 256, q = r % 256, kb = q / 32, nb = q % 32;
        w.src = p.in[23] + (size_t)e * D * D + (size_t)(128 * kb) * D + 32 * nb; w.ld = D; w.dst = (bf16_t*)(p.ws + WS_WDN) + ((size_t)e * D + 32 * nb) * D + 128 * kb; return w; }
}
template <bool EXP>
__device__ __forceinline__ void wconvert(const Params& p, LAS unsigned char* lds, int nitems) {
    const int tid = otid(), lane = tid & 63, wave = __builtin_amdgcn_readfirstlane(tid >> 6);
    LAS float* scr = (LAS float*)(lds + wave * 16896);
    const int gw = blockIdx.x * 8 + wave, NGW = gridDim.x * 8;
    f32x4 va[16], vb[16]; WItem wa, wb;
    int it = gw;
    if (it < nitems) { wa = EXP ? witem_exp(p, it) : witem_setup(p, it); witem_load(wa, va, lane); }
#pragma unroll 1
    for (; it < nitems; it += 2 * NGW) {
        const bool hb = it + NGW < nitems;
        if (hb) { wb = EXP ? witem_exp(p, it + NGW) : witem_setup(p, it + NGW); witem_load(wb, vb, lane); }
        witem_finish(wa, va, scr, lane);
        if (it + 2 * NGW < nitems) { wa = EXP ? witem_exp(p, it + 2 * NGW) : witem_setup(p, it + 2 * NGW); witem_load(wa, va, lane); }
        if (hb) witem_finish(wb, vb, scr, lane);
    }
}
__device__ __forceinline__ void ph_setup(const Params& p, LAS unsigned char* lds) {
    const int tid = otid();
    {
        LAS float* sT = (LAS float*)lds;
        LAS float* red = (LAS float*)(lds + 81920);
        const float* c = p.in[1]; const float* cctx = p.in[3]; const float* w_ada = p.in[4]; const float* b_ada = p.in[5];
        float* mod = (float*)(p.ws + WS_MOD);
        bool did = false;
        for (int item = blockIdx.x; item < 192; item += gridDim.x) {
            if (!did) { for (int idx = tid; idx < 17 * 1024; idx += 512) { const int r = idx >> 10, k = idx & 1023; const float v = r < 16 ? c[r * 1024 + k] : cctx[k]; sT[k * 20 + r] = siluf_(v); } __syncthreads(); did = true; }
            const int col = tid & 31, ks = tid >> 5, j = item * 32 + col;
            float acc[17];
#pragma unroll
            for (int r = 0; r < 17; ++r) acc[r] = 0.f;
            for (int kk = 0; kk < 64; ++kk) { const int k = ks * 64 + kk; const float w = w_ada[(size_t)k * 6144 + j];
#pragma unroll
                for (int r = 0; r < 17; ++r) acc[r] += sT[k * 20 + r] * w; }
#pragma unroll
            for (int r = 0; r < 17; ++r) red[(ks * 17 + r) * 32 + col] = acc[r];
            __syncthreads();
            for (int o = tid; o < 17 * 32; o += 512) { const int r = o >> 5, cc = o & 31; float s = b_ada[item * 32 + cc];
                for (int k2 = 0; k2 < 16; ++k2) s += red[(k2 * 17 + r) * 32 + cc];
                mod[r * 6144 + item * 32 + cc] = s; }
            __syncthreads();
        }
        __syncthreads();
    }
    wconvert<false>(p, lds, 8 * 208 + 2 * 4 * 32 + 8 * 32);
}
__device__ __forceinline__ void ph_wexp(const Params& p, LAS unsigned char* lds) { wconvert<true>(p, lds, NE * 8 * 64 + NE * 8 * 32); }

__device__ __forceinline__ void ph_hl(const Params& p, LAS unsigned char* lds) {
    const int tid = otid(), lane = tid & 63, wave = __builtin_amdgcn_readfirstlane(tid >> 6);
    constexpr int TP = 1025;
    LAS float* tile = (LAS float*)lds;
    const float* w_in = p.in[10];
    const int rt = wave & 1, ksl = wave >> 1;
    float breg[64];
#pragma unroll
    for (int s = 0; s < 64; ++s) breg[s] = w_in[(size_t)(256 * ksl + 4 * s + (lane >> 4)) * NIN + C_MG + (lane & 15)];
    const float* x = p.in[0]; const float* ctx = p.in[2]; const float* wpre = p.in[6]; const float* b_in = p.in[11];
    const float* mod = (const float*)(p.ws + WS_MOD); float* mg = (float*)(p.ws + WS_MG); bf16_t* HL = (bf16_t*)(p.ws + WS_HL);
    f32x4 vg[4][4];
#define HL_LOADG(r0_) do { _Pragma("unroll") for (int tt_ = 0; tt_ < 4; ++tt_) { const int r_ = (r0_) + wave * 4 + tt_; const float* src_ = r_ < NTOK ? x + (size_t)r_ * D : ctx + (size_t)(r_ - NTOK) * D; \
        _Pragma("unroll") for (int j_ = 0; j_ < 4; ++j_) vg[tt_][j_] = __builtin_nontemporal_load((const f32x4*)src_ + lane + 64 * j_); } } while (0)
    if ((int)blockIdx.x < MROWS / 32) HL_LOADG(blockIdx.x * 32);
    for (int grp = blockIdx.x; grp < MROWS / 32; grp += gridDim.x) {
        const int r0 = grp * 32;
        const int b = r0 < NTOK ? (r0 >> 11) : 16;
        const float* sh = mod + b * 6144; const float* sc = sh + 1024;
#pragma unroll
        for (int tt = 0; tt < 4; ++tt) {
            const int rl = wave * 4 + tt, r = r0 + rl;
            f32x4 v[4]; float ss = 0.f;
#pragma unroll
            for (int j = 0; j < 4; ++j) { v[j] = vg[tt][j]; ss += v[j].x * v[j].x + v[j].y * v[j].y + v[j].z * v[j].z + v[j].w * v[j].w; }
            ss = wave_sum(ss); const float rstd = rsqrtf(ss * (1.0f / D) + EPS);
#pragma unroll
            for (int j = 0; j < 4; ++j) { const int ci = 4 * lane + 256 * j;
                const f32x4 wv = *(const f32x4*)(wpre + ci), shv = *(const f32x4*)(sh + ci), scv = *(const f32x4*)(sc + ci);
                LAS float* trow = tile + rl * TP + ci;
                f32x4 h;
#pragma unroll
                for (int i = 0; i < 4; ++i) { h[i] = v[j][i] * rstd * wv[i] * (1.0f + scv[i]) + shv[i]; trow[i] = h[i]; }
                u32x2 o; o.x = cvt_pk_bf16(h[0], h[1]); o.y = cvt_pk_bf16(h[2], h[3]);
                *(u32x2*)(HL + (size_t)r * D + ci) = o; }
        }
        __syncthreads();
        if (grp + (int)gridDim.x < MROWS / 32) HL_LOADG((grp + (int)gridDim.x) * 32);
        f32x4 acc = (f32x4){0.f, 0.f, 0.f, 0.f};
        { const LAS float* ap = tile + (16 * rt + (lane & 15)) * TP + 256 * ksl + (lane >> 4);
#pragma unroll
            for (int s = 0; s < 64; ++s) acc = __builtin_amdgcn_mfma_f32_16x16x4f32(ap[4 * s], breg[s], acc, 0, 0, 0); }
        __syncthreads();
#pragma unroll
        for (int r = 0; r < 4; ++r) tile[(ksl * 32 + 16 * rt + 4 * (lane >> 4) + r) * 16 + (lane & 15)] = acc[r];
        __syncthreads();
        { const int row = tid >> 4, col = tid & 15; mg[(size_t)(r0 + row) * 16 + col] = b_in[C_MG + col] + (tile[row * 16 + col] + tile[(32 + row) * 16 + col]) + (tile[(64 + row) * 16 + col] + tile[(96 + row) * 16 + col]); }
        __syncthreads();
    }
}

__device__ __forceinline__ float logsigf_(float x) { return fminf(x, 0.f) - __logf(1.0f + __expf(-fabsf(x))); }
__device__ __forceinline__ bf16_t tobf(float f) { return (bf16_t)(cvt_pk_bf16(f, 0.f) & 0xffffu); }
__device__ __forceinline__ float ldsbf(const LAS unsigned char* p) { return __uint_as_float(((unsigned)*(const LAS bf16_t*)p) << 16); }
constexpr int PR_HALO = 256, PR_T = 49408, PR_W = 131328, PR_SEG = 131840, PR_SEGSZ = 8192;
static_assert(PR_SEG + PR_SEGSZ <= LDS_BYTES - 16, "prep LDS map");
__device__ __forceinline__ void pr_dma_tile(LAS unsigned char* lds, int ldsoff, const char* gsrc, size_t pitchB, int w, int lane) {
#pragma unroll
    for (int i = 0; i < 2; ++i) { const int r0 = 8 * w + 4 * i;
        __builtin_amdgcn_global_load_lds((const unsigned*)(gsrc + (size_t)(r0 + (lane >> 4)) * pitchB + (lane & 15) * 16), (LAS unsigned*)(lds + ldsoff + r0 * 256), 16, 0, 0); }
}
__device__ __forceinline__ void pr_flush_nat(const LAS unsigned char* lds, int ldsoff, char* gdst, size_t pitchB, int tid) {
#pragma unroll
    for (int ps = 0; ps < 2; ++ps) { const int row = (tid >> 4) + 32 * ps, u = tid & 15; *(u32x4*)(gdst + (size_t)row * pitchB + u * 16) = *(const LAS u32x4*)(lds + ldsoff + row * 256 + u * 16); }
}
__device__ __forceinline__ void pr_flush_tr(const LAS unsigned char* lds, int ldsoff, char* gdst, int tid) {
#pragma unroll
    for (int ps = 0; ps < 2; ++ps) { const int idx = tid + 512 * ps, c = idx >> 3, u = idx & 7; *(u32x4*)(gdst + (size_t)idx * 16) = *(const LAS u32x4*)(lds + ldsoff + c * 128 + ((u ^ (c & 7)) << 4)); }
}
__device__ __forceinline__ f32x2 ldsbf2(const LAS unsigned char* p) { const unsigned w = *(const LAS unsigned*)p; return (f32x2){bf_lo(w), bf_hi(w)}; }
__device__ __forceinline__ f32x2 exp2v(f32x2 x) { return (f32x2){__expf(x.x), __expf(x.y)}; }
__device__ __forceinline__ f32x2 log1mv(f32x2 k) { return (f32x2){__logf(1.0f - k.x), __logf(1.0f - k.y)}; }
__device__ __forceinline__ void pr_tstore8(LAS unsigned char* lds, int ldsoff, int cp, int seg, const f32x2 (&f)[8]) {
    u32x4 a, b;
    a.x = cvt_pk_bf16(f[0].x, f[1].x); a.y = cvt_pk_bf16(f[2].x, f[3].x); a.z = cvt_pk_bf16(f[4].x, f[5].x); a.w = cvt_pk_bf16(f[6].x, f[7].x);
    b.x = cvt_pk_bf16(f[0].y, f[1].y); b.y = cvt_pk_bf16(f[2].y, f[3].y); b.z = cvt_pk_bf16(f[4].y, f[5].y); b.w = cvt_pk_bf16(f[6].y, f[7].y);
    const int c0 = 2 * cp, c1 = 2 * cp + 1;
    *(LAS u32x4*)(lds + ldsoff + c0 * 128 + ((seg ^ (c0 & 7)) << 4)) = a;
    *(LAS u32x4*)(lds + ldsoff + c1 * 128 + ((seg ^ (c1 & 7)) << 4)) = b;
}
__device__ __forceinline__ void pr_conv8p(const LAS unsigned char* halo, const f32x2 (&cwv)[9], bool lat, int cc, int s0, int cp, f32x2 (&o)[8]) {
#pragma unroll
    for (int j = 0; j < 8; ++j) o[j] = (f32x2){0.f, 0.f};
    if (lat) {
        const int gi = cc - 4;
#pragma unroll
        for (int di = 0; di < 3; ++di) {
            const int ii = gi + di - 1; const bool rok = ii >= 0 && ii < 32;
            f32x2 x[10];
#pragma unroll
            for (int jj = 0; jj < 10; ++jj) { const int gj = s0 + jj - 1; const f32x2 v = ldsbf2(halo + di * 16384 + gj * 256 + cp * 4); x[jj] = (rok && gj >= 0 && gj < 64) ? v : (f32x2){0.f, 0.f}; }
#pragma unroll
            for (int dj = 0; dj < 3; ++dj) { const f32x2 w = cwv[di * 3 + dj];
#pragma unroll
                for (int j = 0; j < 8; ++j) o[j] += w * x[j + dj]; }
        }
    } else {
        f32x2 x[10];
#pragma unroll
        for (int jj = 0; jj < 10; ++jj) { const int fl = 64 + s0 + jj - 1, tt = cc * 64 + s0 + jj - 1; const f32x2 v = ldsbf2(halo + fl * 256 + cp * 4); x[jj] = (tt >= 0 && tt < TC) ? v : (f32x2){0.f, 0.f}; }
#pragma unroll
        for (int dj = 0; dj < 3; ++dj) { const f32x2 w = cwv[3 + dj];
#pragma unroll
            for (int j = 0; j < 8; ++j) o[j] += w * x[j + dj]; }
    }
}
#define PR_BAR() do { asm volatile("s_waitcnt lgkmcnt(0)" ::: "memory"); __builtin_amdgcn_s_barrier(); asm volatile("" ::: "memory"); } while (0)
__device__ __forceinline__ void ph_prep(const Params& p, LAS unsigned char* lds) {
    const int tid = otid(), lane = tid & 63, wave = __builtin_amdgcn_readfirstlane(tid >> 6);
    const int cp = tid & 63, seg = tid >> 6, s0 = 8 * seg;
    LAS float* wS = (LAS float*)(lds + PR_W);
    LAS float* segS = (LAS float*)(lds + PR_SEG);
    const char* PD = (const char*)(p.ws + WS_PD); char* QK = (char*)(p.ws + WS_QK);
    const float* mg = (const float*)(p.ws + WS_MG); const float* cw = p.in[12];
    float* GW = (float*)(p.ws + WS_GW); float* G1 = (float*)(p.ws + WS_G1); bf16_t* WB = (bf16_t*)(p.ws + WS_WB);
    float* DEC = (float*)(p.ws + WS_DEC); float* EAL = (float*)(p.ws + WS_EAL);
    constexpr int T0 = PR_T, T1 = PR_T + 16384, T2 = PR_T + 32768, T3 = PR_T + 49152, T4 = PR_T + 65536, H0 = PR_HALO, H1 = PR_HALO + 16384, H2 = PR_HALO + 32768;
    constexpr size_t PDP = (size_t)PD_W * 2;
    for (int unit = blockIdx.x; unit < NB * 36 * 4; unit += gridDim.x) {
        const int h = unit & 3, cc = (unit >> 2) % 36, b = unit / 144;
        const bool lat = cc >= 4; const int u0 = cc * 64; const int row0 = lat ? b * T + (cc - 4) * 64 : NTOK + b * TC + cc * 64;
        const int bh = b * 4 + h;
        const size_t trb = ((size_t)bh * 36 + cc) * 16384;
        {
            const int colk = PD_MK + h * 128;
#pragma unroll
            for (int di = 0; di < 3; ++di) { const int rr = lat ? (cc - 4) + di - 1 : cc + di - 1; const bool ok = lat ? (rr >= 0 && rr < 32) : (rr >= 0 && rr < 4);
                if (ok) pr_dma_tile(lds, PR_HALO + di * 16384, PD + (size_t)(lat ? b * T + rr * 64 : NTOK + b * TC + rr * 64) * PDP + colk * 2, PDP, wave, lane); }
            pr_dma_tile(lds, T0, PD + (size_t)row0 * PDP + (PD_MV + h * 128) * 2, PDP, wave, lane);
        }
        f32x2 wk[9], wq[9];
#pragma unroll
        for (int t9 = 0; t9 < 9; ++t9) { wk[t9] = *(const f32x2*)(cw + t9 * 1024 + PD_MK + h * 128 + 2 * cp); wq[t9] = *(const f32x2*)(cw + t9 * 1024 + PD_MQ + h * 128 + 2 * cp); }
        if (wave < 2) {
            const int dir = wave; const int s = dir ? 63 - lane : lane; const float* g = mg + (size_t)(row0 + s) * 16;
            const float ipre = g[dir * 4 + h], fpre = g[(2 + dir) * 4 + h]; float bs = logsigf_(fpre);
#pragma unroll
            for (int o = 1; o < 64; o <<= 1) { const float tt = __shfl_up(bs, o); if (lane >= o) bs += tt; }
            const float bL = __shfl(bs, 63); const float w = __expf(bL - bs + ipre), g1 = __expf(bs - bL);
            const size_t gi = (size_t)(bh * 2 + dir) * 2304 + u0; wS[dir * 64 + s] = w; GW[gi + s] = w; G1[gi + s] = g1;
            WB[gi + s] = tobf(w);
            if (lane == 63) DEC[(bh * 2 + dir) * 36 + cc] = __expf(bL);
        }
        asm volatile("s_waitcnt vmcnt(0)" ::: "memory"); PR_BAR();
        {
            f32x2 o[8];
            pr_conv8p(lds + PR_HALO, wk, lat, cc, s0, cp, o);
#pragma unroll
            for (int j = 0; j < 8; ++j) { o[j].x = siluf_(o[j].x); o[j].y = siluf_(o[j].y); }
            pr_tstore8(lds, T2, cp, seg, o);
            asm volatile("" ::: "memory");
            f32x2 vf[8];
#pragma unroll
            for (int j = 0; j < 8; ++j) { o[j] = ldsbf2(lds + T0 + (s0 + j) * 256 + cp * 4); vf[j] = o[j] * wS[s0 + j]; }
            pr_tstore8(lds, T3, cp, seg, vf);
            asm volatile("" ::: "memory");
#pragma unroll
            for (int j = 0; j < 8; ++j) vf[j] = o[j] * wS[64 + s0 + j];
            pr_tstore8(lds, T4, cp, seg, vf);
        }
        PR_BAR();
        if (lat) {
#pragma unroll
            for (int di = 0; di < 3; ++di) { const int rr = (cc - 4) + di - 1; if (rr >= 0 && rr < 32) pr_dma_tile(lds, PR_HALO + di * 16384, PD + (size_t)(b * T + rr * 64) * PDP + (PD_MQ + h * 128) * 2, PDP, wave, lane); }
        }
        pr_dma_tile(lds, T0, PD + (size_t)row0 * PDP + (PD_HF + h * 128) * 2, PDP, wave, lane);
        pr_flush_tr(lds, T2, (char*)(p.ws + WS_KT) + trb, tid); pr_flush_tr(lds, T3, (char*)(p.ws + WS_VTF) + trb, tid); pr_flush_tr(lds, T4, (char*)(p.ws + WS_VTB) + trb, tid);
        PR_BAR();
        pr_dma_tile(lds, T2, PD + (size_t)row0 * PDP + (PD_HF + 512 + h * 128) * 2, PDP, wave, lane);
        if (lat) pr_dma_tile(lds, T3, PD + (size_t)row0 * PDP + (PD_HQ + h * 128) * 2, PDP, wave, lane);
        pr_dma_tile(lds, T4, PD + (size_t)row0 * PDP + (PD_HI + h * 128) * 2, PDP, wave, lane);
        if (lat) {
            asm volatile("s_waitcnt vmcnt(6)" ::: "memory"); PR_BAR();
            f32x2 o[8];
            pr_conv8p(lds + PR_HALO, wq, true, cc, s0, cp, o);
#pragma unroll
            for (int j = 0; j < 8; ++j) *(LAS unsigned*)(lds + T1 + (s0 + j) * 256 + cp * 4) = cvt_pk_bf16(siluf_(o[j].x) * 0.08838834764831845f, siluf_(o[j].y) * 0.08838834764831845f);
            PR_BAR();
            pr_flush_nat(lds, T1, QK + (size_t)row0 * (D * 2) + (h * 128) * 2, (size_t)D * 2, tid);
        }
        asm volatile("s_waitcnt vmcnt(0)" ::: "memory"); PR_BAR();
        {
            const int ob = s0 * 256 + cp * 4;
            f32x2 locf = (f32x2){0.f, 0.f}, locb = locf;
            { f32x2 iv[8];
#pragma unroll
                for (int j = 0; j < 8; ++j) { iv[j] = ldsbf2(lds + T4 + ob + j * 256); locf += log1mv(ldsbf2(lds + T0 + ob + j * 256)); locb += log1mv(ldsbf2(lds + T2 + ob + j * 256)); }
                pr_tstore8(lds, H0, cp, seg, iv); }
            *(LAS f32x2*)(segS + seg * 128 + 2 * cp) = locf; *(LAS f32x2*)(segS + (8 + seg) * 128 + 2 * cp) = locb;
            PR_BAR();
            f32x2 pf = (f32x2){0.f, 0.f}, tf = pf, pb = pf, tbk = pf;
#pragma unroll
            for (int sg = 0; sg < 8; ++sg) { const f32x2 a = *(const LAS f32x2*)(segS + sg * 128 + 2 * cp), bq = *(const LAS f32x2*)(segS + (8 + sg) * 128 + 2 * cp); tf += a; tbk += bq; if (sg < seg) { pf += a; pb += bq; } }
            f32x2 ke[8];
            {
                f32x2 run = pf;
#pragma unroll
                for (int j = 0; j < 8; ++j) { const f32x2 kk = ldsbf2(lds + T0 + ob + j * 256), qv = ldsbf2(lds + T3 + ob + j * 256); run += log1mv(kk);
                    f32x2 x = tf - run; x.x = fmaxf(x.x, -80.f); x.y = fmaxf(x.y, -80.f);
                    ke[j] = kk * exp2v(x); const f32x2 qp = qv * exp2v(-x);
                    *(LAS unsigned*)(lds + T1 + ob + j * 256) = lat ? cvt_pk_bf16(qp.x, qp.y) : 0u; }
                pr_tstore8(lds, H1, cp, seg, ke);
            }
            asm volatile("" ::: "memory");
            {
                f32x2 E = pb;
#pragma unroll
                for (int j = 0; j < 8; ++j) { const f32x2 kk = ldsbf2(lds + T2 + ob + j * 256), qv = ldsbf2(lds + T3 + ob + j * 256);
                    f32x2 x = E; x.x = fmaxf(x.x, -80.f); x.y = fmaxf(x.y, -80.f); E += log1mv(kk);
                    ke[j] = kk * exp2v(x); const f32x2 qp = qv * exp2v(-x);
                    *(LAS unsigned*)(lds + T3 + ob + j * 256) = lat ? cvt_pk_bf16(qp.x, qp.y) : 0u; }
                pr_tstore8(lds, H2, cp, seg, ke);
            }
            if (seg == 0) { *(f32x2*)(EAL + ((size_t)(bh * 2 + 0) * 36 + cc) * 128 + 2 * cp) = exp2v(tf); *(f32x2*)(EAL + ((size_t)(bh * 2 + 1) * 36 + cc) * 128 + 2 * cp) = exp2v(tbk); }
        }
        PR_BAR();
        pr_flush_tr(lds, H0, (char*)(p.ws + WS_IT) + trb, tid); pr_flush_tr(lds, H1, (char*)(p.ws + WS_KEFT) + trb, tid); pr_flush_tr(lds, H2, (char*)(p.ws + WS_KEBT) + trb, tid);
        if (lat) { const size_t no = (size_t)row0 * 1024 + (h * 128) * 2;
            pr_flush_nat(lds, T1, (char*)(p.ws + WS_QPFN) + no, 1024, tid); pr_flush_nat(lds, T3, (char*)(p.ws + WS_QPBN) + no, 1024, tid); }
        PR_BAR();
    }
}

#undef PR_BAR
#define MFMA16(a, b, c) __builtin_amdgcn_mfma_f32_16x16x32_bf16((a), (b), (c), 0, 0, 0)
constexpr int SC_ST = 0, SC_BUF = 32768, SC_BUFSZ = 32768, SC_KT = 0, SC_VT = 16384;
constexpr int SC_VEC = SC_BUF + 3 * SC_BUFSZ, SC_VECSZ = 1536, SC_GW = 0, SC_G1 = 256, SC_WB = 512, SC_EAL = 1024, SC_NS = SC_VEC + 3 * SC_VECSZ, SC_DUMMY = SC_NS + 512;
static_assert(SC_DUMMY + 256 <= LDS_BYTES - 16, "scan LDS map");
typedef unsigned short u16x4 __attribute__((ext_vector_type(4)));
template <bool MLSTM>
__device__ __forceinline__ void scan2_item(const Params& p, LAS unsigned char* lds, int b, int h, int dir) {
    const int tid = otid(), lane = tid & 63, w = __builtin_amdgcn_readfirstlane(tid >> 6), j15 = lane & 15, kq = lane >> 4;
    const int dh = w >> 2, vq = w & 3, rb = w & 3, vh = w >> 2;
    const int bh = b * 4 + h, bhd = bh * 2 + dir;
    const int npitch = MLSTM ? D : 512;
    const bf16_t* QNarr = MLSTM ? (const bf16_t*)(p.ws + WS_QK) + h * 128 : (const bf16_t*)(p.ws + (dir ? WS_QPBN : WS_QPFN)) + h * 128;
    const bf16_t* KTarr = (const bf16_t*)(p.ws + (MLSTM ? WS_KT : (dir ? WS_KEBT : WS_KEFT))) + (size_t)bh * 36 * 8192;
    const bf16_t* VTarr = (const bf16_t*)(p.ws + (MLSTM ? (dir ? WS_VTB : WS_VTF) : WS_IT)) + (size_t)bh * 36 * 8192;
    const float* GWarr = (const float*)(p.ws + WS_GW) + (size_t)bhd * 2304; const float* G1arr = (const float*)(p.ws + WS_G1) + (size_t)bhd * 2304;
    const bf16_t* WBarr = (const bf16_t*)(p.ws + WS_WB) + (size_t)bhd * 2304; const float* EALarr = (const float*)(p.ws + WS_EAL) + (size_t)bhd * 36 * 128;
    const float* DEC = (const float*)(p.ws + WS_DEC) + bhd * 36;
    bf16_t* HSo = (bf16_t*)(p.ws + WS_HS) + (size_t)((MLSTM ? 0 : 2) + dir) * NTOK * 512 + h * 128;
    unsigned doff[4];
#pragma unroll
    for (int i = 0; i < 4; ++i) { const int idx = (w * 4 + i) & 15; doff[i] = (unsigned)(((16 * (idx >> 1) + j15) * 64 + 32 * (idx & 1) + 8 * kq) * 2); }
    const unsigned trL = (unsigned)((kq >> 1) * 2048 + (kq & 1) * 128 + ((lane & 15) >> 2) * 16 + ((lane & 3) >> 1) * 256 + (lane & 1) * 8);
    const unsigned vtL = (unsigned)(j15 * 16 + (kq >> 1) * 256 + (kq & 1) * 8);
#define SC_CC(st) (dir == 0 ? (st) : ((st) < 4 ? 3 - (st) : 39 - (st)))
#define SC_ROW0(cc) ((cc) >= 4 ? b * T + ((cc) - 4) * 64 : NTOK + b * TC + (cc) * 64)
#define SC_DMA(st, bufi) do { const int cc_ = SC_CC(st); const unsigned bo_ = SC_BUF + (bufi) * SC_BUFSZ; \
        const char* kt_ = (const char*)(KTarr + (size_t)cc_ * 8192); const char* vt_ = (const char*)(VTarr + (size_t)cc_ * 8192); \
        _Pragma("unroll") for (int i = 0; i < 4; ++i) { const int f = w * 4 + i; const char* g_ = (f < 16 ? kt_ : vt_) + doff[i]; \
            __builtin_amdgcn_global_load_lds((const unsigned*)g_, (LAS unsigned*)(lds + bo_ + f * 1024), 16, 0, 0); } \
        const unsigned vo_ = SC_VEC + (bufi) * SC_VECSZ; const unsigned* vs_ = (const unsigned*)DEC; unsigned vd_ = SC_DUMMY; int lm_ = 0; \
        if (MLSTM) { if (w == 0) { vs_ = (const unsigned*)(GWarr + cc_ * 64); vd_ = vo_ + SC_GW; lm_ = 1; } if (w == 1) { vs_ = (const unsigned*)(G1arr + cc_ * 64); vd_ = vo_ + SC_G1; lm_ = 1; } \
            if (w == 2) { vs_ = (const unsigned*)(WBarr + cc_ * 64); vd_ = vo_ + SC_WB; lm_ = 1; } if (w == 3) { vs_ = (const unsigned*)(DEC + cc_); vd_ = vo_ + SC_EAL; } } \
        else { if (w == 3 || w == 4) { vs_ = (const unsigned*)(EALarr + cc_ * 128 + (w - 3) * 64); vd_ = vo_ + SC_EAL + (w - 3) * 256; lm_ = 1; } } \
        __builtin_amdgcn_global_load_lds(vs_ + lm_ * lane, (LAS unsigned*)(lds + vd_), 4, 0, 0); } while (0)
#define SC_LOADQ(Q, st) do { const int cc_ = SC_CC(st); const bf16_t* qp_ = QNarr + (size_t)(SC_ROW0(cc_) + 16 * rb + j15) * npitch + 8 * kq; \
        asm volatile("global_load_dwordx4 %0, %4, off\n\tglobal_load_dwordx4 %1, %4, off offset:64\n\tglobal_load_dwordx4 %2, %4, off offset:128\n\tglobal_load_dwordx4 %3, %4, off offset:192" \
            : "=&v"(Q[0]), "=&v"(Q[1]), "=&v"(Q[2]), "=&v"(Q[3]) : "v"(qp_) : "memory"); } while (0)
    f32x4 acc[4][2], accn = (f32x4){0.f, 0.f, 0.f, 0.f};
#pragma unroll
    for (int dt = 0; dt < 4; ++dt)
#pragma unroll
        for (int vt = 0; vt < 2; ++vt) acc[dt][vt] = (f32x4){0.f, 0.f, 0.f, 0.f};
    bf16x8 Qa[4], Qb[4];
#pragma unroll
    for (int ks = 0; ks < 4; ++ks) { Qa[ks] = (bf16x8){0, 0, 0, 0, 0, 0, 0, 0}; Qb[ks] = Qa[ks]; }
    __syncthreads();
    if (SC_CC(0) >= 4) SC_LOADQ(Qa, 0);
    SC_DMA(0, 0); SC_DMA(1, 1);
#define SC_WAITFOR(s_) do { if ((s_) == 0) asm volatile("s_waitcnt vmcnt(5)" ::: "memory"); \
        else if ((s_) + 1 < 36) { if (SC_CC((s_) - 1) >= 4) asm volatile("s_waitcnt vmcnt(9)" ::: "memory"); else asm volatile("s_waitcnt vmcnt(5)" ::: "memory"); } \
        else asm volatile("s_waitcnt vmcnt(0)" ::: "memory"); } while (0)
    SC_WAITFOR(0);
#define SC_STEP(Q, QN, st) do { const int cc = SC_CC(st); const bool lat = cc >= 4; const int bi = (st) % 3; \
        const LAS unsigned char* B_ = lds + SC_BUF + bi * SC_BUFSZ; const LAS unsigned char* V_ = lds + SC_VEC + bi * SC_VECSZ; \
        __builtin_amdgcn_s_barrier(); asm volatile("" ::: "memory"); \
        _Pragma("unroll") for (int ks = 0; ks < 4; ++ks) asm volatile("" : "+v"(Q[ks])); \
        if ((st) + 1 < 36 && SC_CC((st) + 1) >= 4) SC_LOADQ(QN, (st) + 1); \
        if ((st) + 2 < 36) { SC_DMA((st) + 2, ((st) + 2) % 3); } \
          \
        if (MLSTM) { const float dec = *(const LAS float*)(V_ + SC_EAL); _Pragma("unroll") for (int dt = 0; dt < 4; ++dt) _Pragma("unroll") for (int vt = 0; vt < 2; ++vt) acc[dt][vt] *= dec; accn *= dec; } \
        else { _Pragma("unroll") for (int dt = 0; dt < 4; ++dt) { const f32x4 e = *(const LAS f32x4*)(V_ + SC_EAL + (64 * dh + 16 * dt + 4 * kq) * 4); _Pragma("unroll") for (int vt = 0; vt < 2; ++vt) acc[dt][vt] *= e; } } \
        if (lat) { _Pragma("unroll") for (int dt = 0; dt < 4; ++dt) _Pragma("unroll") for (int vt = 0; vt < 2; ++vt) { u32x2 v_; v_.x = cvt_pk_bf16(acc[dt][vt][0], acc[dt][vt][1]); v_.y = cvt_pk_bf16(acc[dt][vt][2], acc[dt][vt][3]); \
                *(LAS u32x2*)(lds + SC_ST + (32 * vq + 16 * vt + j15) * 256 + (((8 * dh + 2 * dt + (kq >> 1)) ^ j15) << 4) + 8 * (kq & 1)) = v_; } \
            if (MLSTM && j15 == 0) *(LAS f32x4*)(lds + SC_NS + (16 * (4 * dh + vq) + 4 * kq) * 4) = accn; } \
        asm volatile("s_waitcnt lgkmcnt(0)" ::: "memory"); __builtin_amdgcn_s_barrier(); asm volatile("" ::: "memory"); \
        if (lat) { const int t = 16 * rb + j15; f32x4 Gt[4]; const unsigned tra_ = (unsigned)(size_t)(B_ + SC_KT) + trL; \
            _Pragma("unroll") for (int s4 = 0; s4 < 4; ++s4) { Gt[s4] = (f32x4){0.f, 0.f, 0.f, 0.f}; u16x4 k0_[4], k1_[4]; \
                _Pragma("unroll") for (int ks = 0; ks < 4; ++ks) { const unsigned a_ = tra_ + ks * 4096 + (s4 >> 1) * 1024 + (s4 & 1) * 512; \
                    asm volatile("ds_read_b64_tr_b16 %0, %2\n\tds_read_b64_tr_b16 %1, %2 offset:64" : "=&v"(k0_[ks]), "=&v"(k1_[ks]) : "v"(a_) : "memory"); } \
                asm volatile("s_waitcnt lgkmcnt(0)" ::: "memory"); __builtin_amdgcn_sched_barrier(0); \
                _Pragma("unroll") for (int ks = 0; ks < 4; ++ks) { const u32x2 lo_ = __builtin_bit_cast(u32x2, k0_[ks]), hi_ = __builtin_bit_cast(u32x2, k1_[ks]); u32x4 kk_; kk_.x = lo_.x; kk_.y = lo_.y; kk_.z = hi_.x; kk_.w = hi_.y; \
                    Gt[s4] = MFMA16(__builtin_bit_cast(bf16x8, kk_), Q[ks], Gt[s4]); } } \
            float dsum = 0.f; unsigned pk_[8]; \
            _Pragma("unroll") for (int s4 = 0; s4 < 4; ++s4) { f32x4 wv = (f32x4){0.f, 0.f, 0.f, 0.f}; if (MLSTM) wv = *(const LAS f32x4*)(V_ + SC_GW + (16 * s4 + 4 * kq) * 4); float gm[4]; \
                _Pragma("unroll") for (int r = 0; r < 4; ++r) { const int s = 16 * s4 + 4 * kq + r; const bool keep = dir == 0 ? (s <= t) : (s >= t); gm[r] = keep ? Gt[s4][r] : 0.f; dsum += gm[r] * wv[r]; } \
                pk_[2 * s4] = cvt_pk_bf16(gm[0], gm[1]); pk_[2 * s4 + 1] = cvt_pk_bf16(gm[2], gm[3]); } \
            bf16x8 Pf[2]; { u32x4 t0; t0.x = pk_[0]; t0.y = pk_[1]; t0.z = pk_[2]; t0.w = pk_[3]; Pf[0] = __builtin_bit_cast(bf16x8, t0); u32x4 t1; t1.x = pk_[4]; t1.y = pk_[5]; t1.z = pk_[6]; t1.w = pk_[7]; Pf[1] = __builtin_bit_cast(bf16x8, t1); } \
            f32x4 Ot[4]; \
            _Pragma("unroll") for (int vt = 0; vt < 4; ++vt) { Ot[vt] = (f32x4){0.f, 0.f, 0.f, 0.f}; const int v8 = 4 * vh + vt; \
                _Pragma("unroll") for (int ks = 0; ks < 4; ++ks) Ot[vt] = MFMA16(*(const LAS bf16x8*)(lds + SC_ST + (16 * v8 + j15) * 256 + (((4 * ks + kq) ^ j15) << 4)), Q[ks], Ot[vt]); \
                _Pragma("unroll") for (int ks = 0; ks < 2; ++ks) { const LAS unsigned char* vp_ = B_ + SC_VT + vtL + v8 * 2048 + ks * 1024; const u32x2 lo_ = *(const LAS u32x2*)vp_, hi_ = *(const LAS u32x2*)(vp_ + 512); \
                    u32x4 vv_; vv_.x = lo_.x; vv_.y = lo_.y; vv_.z = hi_.x; vv_.w = hi_.y; Ot[vt] = MFMA16(__builtin_bit_cast(bf16x8, vv_), Pf[ks], Ot[vt]); } \
                asm volatile("" ::: "memory"); } \
            float sc = 1.0f; \
            if (MLSTM) { float nint = 0.f; \
                _Pragma("unroll") for (int ks = 0; ks < 4; ++ks) { const f32x4 n0 = *(const LAS f32x4*)(lds + SC_NS + (32 * ks + 8 * kq) * 4), n1 = *(const LAS f32x4*)(lds + SC_NS + (32 * ks + 8 * kq + 4) * 4); float q[8]; unpack8(__builtin_bit_cast(u32x4, Q[ks]), q); \
                    nint += q[0] * n0[0] + q[1] * n0[1] + q[2] * n0[2] + q[3] * n0[3] + q[4] * n1[0] + q[5] * n1[1] + q[6] * n1[2] + q[7] * n1[3]; } \
                float tot = dsum + nint; tot += __shfl_xor(tot, 16); tot += __shfl_xor(tot, 32); \
                const float g1 = *(const LAS float*)(V_ + SC_G1 + t * 4); sc = g1 / fmaxf(fabsf(g1 * tot), 1.0f); } \
            bf16_t* op_ = HSo + (size_t)(SC_ROW0(cc) + t) * 512 + 64 * vh + 4 * kq; \
            _Pragma("unroll") for (int vt = 0; vt < 4; ++vt) { u32x2 o_; o_.x = cvt_pk_bf16(Ot[vt][0] * sc, Ot[vt][1] * sc); o_.y = cvt_pk_bf16(Ot[vt][2] * sc, Ot[vt][3] * sc); *(u32x2*)(op_ + 16 * vt) = o_; } } \
          \
        _Pragma("unroll") for (int ks = 0; ks < 2; ++ks) { bf16x8 vf_[2]; _Pragma("unroll") for (int vt = 0; vt < 2; ++vt) vf_[vt] = *(const LAS bf16x8*)(B_ + SC_VT + ((2 * vq + vt) * 2 + ks) * 1024 + lane * 16); \
            _Pragma("unroll") for (int dt = 0; dt < 4; ++dt) { const bf16x8 kf_ = *(const LAS bf16x8*)(B_ + SC_KT + ((4 * dh + dt) * 2 + ks) * 1024 + lane * 16); \
                _Pragma("unroll") for (int vt = 0; vt < 2; ++vt) acc[dt][vt] = MFMA16(kf_, vf_[vt], acc[dt][vt]); } \
            if (MLSTM) { const bf16x8 kn_ = *(const LAS bf16x8*)(B_ + SC_KT + ((4 * dh + vq) * 2 + ks) * 1024 + lane * 16); bf16x8 wf_ = *(const LAS bf16x8*)(V_ + SC_WB + (32 * ks + 8 * kq) * 2); \
                if (j15 != 0) wf_ = (bf16x8){0, 0, 0, 0, 0, 0, 0, 0}; accn = MFMA16(kn_, wf_, accn); } } \
        SC_WAITFOR((st) + 1); \
    } while (0)
#pragma unroll 1
    for (int step = 0; step < 36; step += 2) { SC_STEP(Qa, Qb, step); SC_STEP(Qb, Qa, step + 1); }
    asm volatile("s_waitcnt vmcnt(0) lgkmcnt(0)" ::: "memory");
#undef SC_STEP
#undef SC_WAITFOR
#undef SC_LOADQ
#undef SC_DMA
#undef SC_ROW0
#undef SC_CC
}
__device__ __forceinline__ void ph_scan2(const Params& p, LAS unsigned char* lds) {
    for (int item = blockIdx.x; item < 256; item += gridDim.x) {
        const int kind = item >> 7, r = item & 127, b = r >> 3, h = (r >> 1) & 3, dir = r & 1;
        if (kind == 0) scan2_item<true>(p, lds, b, h, dir); else scan2_item<false>(p, lds, b, h, dir);
    }
    __syncthreads();
}

__device__ __forceinline__ void ph_merge(const Params& p) {
    const int tid = otid(), lane = tid & 63, wave = __builtin_amdgcn_readfirstlane(tid >> 6);
    const bf16_t* PL = (const bf16_t*)(p.ws + WS_PL); const bf16_t* HS = (const bf16_t*)(p.ws + WS_HS); bf16_t* AB = (bf16_t*)(p.ws + WS_AB);
    const float* m_norm = p.in[14]; const float* h_norm = p.in[15];
    const int gw = blockIdx.x * 8 + wave, NGW = gridDim.x * 8, c0 = lane * 8;
    u32x4 n0[2], n1[2], ng[2];
#define MG_LOAD(tok_) do { _Pragma("unroll") for (int kind_ = 0; kind_ < 2; ++kind_) { n0[kind_] = __builtin_nontemporal_load((const u32x4*)(HS + ((size_t)(2 * kind_) * NTOK + (tok_)) * 512 + c0)); \
        n1[kind_] = __builtin_nontemporal_load((const u32x4*)(HS + ((size_t)(2 * kind_ + 1) * NTOK + (tok_)) * 512 + c0)); ng[kind_] = *(const u32x4*)(PL + (size_t)(tok_) * PL_W + (kind_ ? PL_HG : PL_MO) + c0); } } while (0)
    if (gw < NTOK) MG_LOAD(gw);
    for (int tok = gw; tok < NTOK; tok += NGW) {
        u32x4 c0r[2], c1r[2], cgr[2];
#pragma unroll
        for (int kind = 0; kind < 2; ++kind) { c0r[kind] = n0[kind]; c1r[kind] = n1[kind]; cgr[kind] = ng[kind]; }
        if (tok + NGW < NTOK) MG_LOAD(tok + NGW);
#pragma unroll
        for (int kind = 0; kind < 2; ++kind) {
            const u32x4 r0 = c0r[kind], r1 = c1r[kind];
            const u32x4 rg = cgr[kind];
            const float* nw = (kind ? h_norm : m_norm) + c0; const f32x4 w0 = *(const f32x4*)nw, w1 = *(const f32x4*)(nw + 4);
            float a[8], b[8], g[8]; unpack8(r0, a); unpack8(r1, b); unpack8(rg, g);
            float ss = 0.f;
#pragma unroll
            for (int i = 0; i < 8; ++i) { a[i] += b[i]; ss += a[i] * a[i]; }
            ss += __shfl_xor(ss, 1); ss += __shfl_xor(ss, 2); ss += __shfl_xor(ss, 4); ss += __shfl_xor(ss, 8);
            const float rstd = rsqrtf(ss * (1.0f / 128.0f) + EPS);
#pragma unroll
            for (int i = 0; i < 8; ++i) a[i] = a[i] * rstd * (i < 4 ? w0[i] : w1[i - 4]) * g[i];
            *(u32x4*)(AB + ((size_t)kind * NTOK + tok) * 512 + c0) = pack8(a);
        }
    }
}

typedef float f32x16 __attribute__((ext_vector_type(16)));
__device__ __forceinline__ void ph_post(const Params& p, LAS unsigned char* lds) {
    const int tid = otid(), lane = tid & 63, wave = __builtin_amdgcn_readfirstlane(tid >> 6);
    constexpr int TP = 1025;
    LAS float* tile = (LAS float*)lds;
    LAS float* vec = (LAS float*)(lds + 131328);
    LAS int* hist = (LAS int*)(lds + 131328 + 12288);
    const float* w_router = p.in[19]; const float* b_router = p.in[20];
    float breg[64];
#pragma unroll
    for (int s = 0; s < 64; ++s) breg[s] = w_router[(size_t)(128 * wave + 2 * s + (lane >> 5)) * 32 + (lane & 31)];
    const float* x = p.in[0]; const float* wpost = p.in[7]; const float* wfpre = p.in[8];
    const float* mod = (const float*)(p.ws + WS_MOD); const bf16_t* YL = (const bf16_t*)(p.ws + WS_YL); bf16_t* HL2 = (bf16_t*)(p.ws + WS_HL);
    int* top_e = (int*)(p.ws + WS_TOPE); float* top_w = (float*)(p.ws + WS_TOPW); int* cntWG = (int*)(p.ws + WS_CNT);
    u32x2 yrg[4][4]; f32x4 xrg[4][4];
#define PO_LOADG(tok0_) do { _Pragma("unroll") for (int tt_ = 0; tt_ < 4; ++tt_) { const u32x2* yrow_ = (const u32x2*)(YL + (size_t)((tok0_) + tt_) * D); const f32x4* xrow_ = (const f32x4*)(x + (size_t)((tok0_) + tt_) * D); \
        _Pragma("unroll") for (int j_ = 0; j_ < 4; ++j_) { yrg[tt_][j_] = __builtin_nontemporal_load(yrow_ + lane + 64 * j_); xrg[tt_][j_] = __builtin_nontemporal_load(xrow_ + lane + 64 * j_); } } } while (0)
    if ((int)blockIdx.x < 256) PO_LOADG(blockIdx.x * 128 + wave * 4);
    for (int blk = blockIdx.x; blk < 256; blk += gridDim.x) {
        const float* mb = mod + (blk >> 4) * 6144;
        for (int i = tid; i < 1024; i += 512) { vec[i] = mb[2048 + i] * wpost[i]; vec[1024 + i] = wfpre[i] * (1.0f + mb[4096 + i]); vec[2048 + i] = mb[3072 + i]; }
        if (tid < 32) hist[tid] = 0;
        __syncthreads();
#pragma unroll 1
        for (int g = 0; g < 4; ++g) {
#pragma unroll
            for (int tt = 0; tt < 4; ++tt) {
                const int tl = wave * 4 + tt, tok = blk * 128 + g * 32 + tl;
                u32x2* orow = (u32x2*)(p.ws + WS_X1B) + (size_t)tok * (D / 4);
                f32x4 yv[4], xv[4]; float ss = 0.f;
#pragma unroll
                for (int j = 0; j < 4; ++j) { const u32x2 yr = yrg[tt][j]; yv[j] = (f32x4){bf_lo(yr.x), bf_hi(yr.x), bf_lo(yr.y), bf_hi(yr.y)}; xv[j] = xrg[tt][j];
                    ss += yv[j].x * yv[j].x + yv[j].y * yv[j].y + yv[j].z * yv[j].z + yv[j].w * yv[j].w; }
                ss = wave_sum(ss); const float rstd = rsqrtf(ss * (1.0f / D) + EPS);
                float ss2 = 0.f;
#pragma unroll
                for (int j = 0; j < 4; ++j) { const f32x4 gw = *(const LAS f32x4*)(vec + 4 * lane + 256 * j);
#pragma unroll
                    for (int i = 0; i < 4; ++i) { xv[j][i] = xv[j][i] + gw[i] * (yv[j][i] * rstd); ss2 += xv[j][i] * xv[j][i]; }
                    { u32x2 xo; xo.x = cvt_pk_bf16(xv[j][0], xv[j][1]); xo.y = cvt_pk_bf16(xv[j][2], xv[j][3]); __builtin_nontemporal_store(xo, orow + lane + 64 * j); } }
                ss2 = wave_sum(ss2); const float rstd2 = rsqrtf(ss2 * (1.0f / D) + EPS);
#pragma unroll
                for (int j = 0; j < 4; ++j) { const f32x4 a2 = *(const LAS f32x4*)(vec + 1024 + 4 * lane + 256 * j), s2 = *(const LAS f32x4*)(vec + 2048 + 4 * lane + 256 * j);
                    LAS float* trow = tile + tl * TP + 4 * lane + 256 * j;
#pragma unroll
                    for (int i = 0; i < 4; ++i) { yv[j][i] = xv[j][i] * rstd2 * a2[i] + s2[i]; trow[i] = yv[j][i]; }
                    u32x2 o; o.x = cvt_pk_bf16(yv[j][0], yv[j][1]); o.y = cvt_pk_bf16(yv[j][2], yv[j][3]);
                    *(u32x2*)(HL2 + (size_t)tok * D + 4 * lane + 256 * j) = o; }
            }
            __syncthreads();
            { const int ng = g + 1, nblk = ng < 4 ? blk : blk + (int)gridDim.x; if (nblk < 256) PO_LOADG(nblk * 128 + (ng & 3) * 32 + wave * 4); }
            f32x16 acc;
#pragma unroll
            for (int r = 0; r < 16; ++r) acc[r] = 0.f;
            { const LAS float* ap = tile + (lane & 31) * TP + 128 * wave + (lane >> 5);
#pragma unroll
                for (int s = 0; s < 64; ++s) acc = __builtin_amdgcn_mfma_f32_32x32x2f32(ap[2 * s], breg[s], acc, 0, 0, 0); }
            __syncthreads();
#pragma unroll
            for (int r = 0; r < 16; ++r) tile[(wave * 32 + (r & 3) + 8 * (r >> 2) + 4 * (lane >> 5)) * 32 + (lane & 31)] = acc[r];
            __syncthreads();
#pragma unroll
            for (int rr = 0; rr < 2; ++rr) { const int o = tid + 512 * rr; float sa = b_router[o & 31];
#pragma unroll
                for (int w8 = 0; w8 < 8; ++w8) sa += tile[w8 * 1024 + o];
                tile[8192 + (o >> 5) * 33 + (o & 31)] = sa; }
            __syncthreads();
#pragma unroll 1
            for (int tt = 0; tt < 4; ++tt) {
                const int tl = wave * 4 + tt, tok = blk * 128 + g * 32 + tl;
                const int ci = lane >> 1; float cv = tile[8192 + tl * 33 + ci];
                float tv[4]; int ti[4];
#pragma unroll
                for (int k = 0; k < 4; ++k) { float bv = cv; int bi = ci;
#pragma unroll
                    for (int o = 1; o < 64; o <<= 1) { const float ov = __shfl_xor(bv, o); const int oi = __shfl_xor(bi, o); const bool take = (ov > bv) || (ov == bv && oi < bi); bv = take ? ov : bv; bi = take ? oi : bi; }
                    tv[k] = bv; ti[k] = bi; cv = (ci == bi) ? -3.0e38f : cv; }
                const float e1 = __expf(tv[1] - tv[0]), e2 = __expf(tv[2] - tv[0]), e3 = __expf(tv[3] - tv[0]); const float inv = 1.0f / (1.0f + e1 + e2 + e3);
                if (lane == 0) { *(int4*)(top_e + (size_t)tok * 4) = make_int4(ti[0], ti[1], ti[2], ti[3]); *(f32x4*)(top_w + (size_t)tok * 4) = (f32x4){inv, e1 * inv, e2 * inv, e3 * inv};
#pragma unroll
                    for (int k = 0; k < 4; ++k) __hip_atomic_fetch_add(&hist[ti[k]], 1, __ATOMIC_RELAXED, __HIP_MEMORY_SCOPE_WORKGROUP); }
            }
            __syncthreads();
        }
        if (tid < 32) cntWG[blk * 32 + tid] = hist[tid];
        __syncthreads();
    }
}

__device__ __forceinline__ void ph_scatter(const Params& p, LAS unsigned char* lds) {
    const int tid = otid(), lane = tid & 63, wave = __builtin_amdgcn_readfirstlane(tid >> 6);
    LAS int* sm = (LAS int*)lds;
    const int* cntWG = (const int*)(p.ws + WS_CNT); const int* top_e = (const int*)(p.ws + WS_TOPE); const float* top_w = (const float*)(p.ws + WS_TOPW);
    int* dest_arr = (int*)(p.ws + WS_DEST); float* pw = (float*)(p.ws + WS_PW); int* tab = (int*)(p.ws + WS_TAB);
    int* ptok = (int*)(p.ws + WS_PTOK);
    for (int blk = blockIdx.x; blk < 256; blk += gridDim.x) {
        if (tid < 32) { int tot = 0, bef = 0; for (int w = 0; w < 256; ++w) { const int c = cntWG[w * 32 + tid]; tot += c; bef += (w < blk) ? c : 0; } sm[tid] = tot; sm[32 + tid] = bef; }
        __syncthreads();
        if (tid == 0) { int run = 0; for (int e = 0; e < 32; ++e) { sm[96 + e] = run; sm[64 + e] = run + sm[32 + e]; run += (sm[e] + 255) & ~255; } if (blk == 0) tab[0] = run >> 8; }
        __syncthreads();
        if (blk == 0 && tid < 32) { const int b0 = sm[96 + tid] >> 8, nb = (sm[tid] + 255) >> 8; for (int i = 0; i < nb; ++i) tab[1 + b0 + i] = tid;
            for (int i = sm[tid]; i < nb * 256; ++i) ptok[sm[96 + tid] + i] = 0; }
        const int tok = blk * 128 + (tid >> 2), k = tid & 3;
        const int e = top_e[(size_t)tok * 4 + k];
        int rank = 0;
        for (int ee = 0; ee < 32; ++ee) { const unsigned long long mask = __ballot(e == ee); if (e == ee) rank = __popcll(mask & ((1ull << lane) - 1ull)); if (lane == 0) sm[128 + wave * 32 + ee] = __popcll(mask); }
        __syncthreads();
        int off = 0; for (int w = 0; w < wave; ++w) off += sm[128 + w * 32 + e];
        const int dest = sm[64 + e] + off + rank;
        dest_arr[(size_t)tok * 4 + k] = dest; pw[dest] = top_w[(size_t)tok * 4 + k]; ptok[dest] = tok;
        __syncthreads();
    }
}

__device__ __forceinline__ void ph_combine(const Params& p) {
    const int tid = otid(), lane = tid & 63, wave = __builtin_amdgcn_readfirstlane(tid >> 6);
    const bf16_t* YB = (const bf16_t*)(p.ws + WS_YB); const int* dest_arr = (const int*)(p.ws + WS_DEST); const float* mod = (const float*)(p.ws + WS_MOD); const float* wpost2 = p.in[9];
    const int gw = blockIdx.x * 8 + wave, NGW = gridDim.x * 8;
    for (int tok = gw; tok < NTOK; tok += NGW) {
        const int b = tok >> 11; const float* g2 = mod + b * 6144 + 5120;
        const int4 dd = *(const int4*)(dest_arr + (size_t)tok * 4); const int ds[4] = {dd.x, dd.y, dd.z, dd.w};
        float y[2][8];
#pragma unroll
        for (int s = 0; s < 2; ++s)
#pragma unroll
            for (int i = 0; i < 8; ++i) y[s][i] = 0.f;
#pragma unroll
        for (int k = 0; k < 4; ++k)
#pragma unroll
            for (int s = 0; s < 2; ++s) { const u32x4 r = __builtin_nontemporal_load((const u32x4*)(YB + (size_t)ds[k] * D + s * 512 + lane * 8)); float f[8]; unpack8(r, f);
#pragma unroll
                for (int i = 0; i < 8; ++i) y[s][i] += f[i]; }
        float ss = 0.f;
#pragma unroll
        for (int s = 0; s < 2; ++s)
#pragma unroll
            for (int i = 0; i < 8; ++i) ss += y[s][i] * y[s][i];
        ss = wave_sum(ss); const float rstd = rsqrtf(ss * (1.0f / D) + EPS);
#pragma unroll
        for (int s = 0; s < 2; ++s)
#pragma unroll
            for (int q = 0; q < 2; ++q) { const int ci = s * 512 + lane * 8 + 4 * q; float* op = p.out + (size_t)tok * D + ci;
                const u32x2 xr = __builtin_nontemporal_load((const u32x2*)((const bf16_t*)(p.ws + WS_X1B) + (size_t)tok * D + ci)); const f32x4 x1 = (f32x4){bf_lo(xr.x), bf_hi(xr.x), bf_lo(xr.y), bf_hi(xr.y)};
                const f32x4 gv = *(const f32x4*)(g2 + ci), wv = *(const f32x4*)(wpost2 + ci); f32x4 o;
#pragma unroll
                for (int i = 0; i < 4; ++i) o[i] = x1[i] + gv[i] * (y[s][4 * q + i] * rstd * wv[i]);
                __builtin_nontemporal_store(o, (f32x4*)op); }
    }
}

#define XB_TMO      128
#define XB_XCNT(j)  (256  + 64 * (j))
#define XB_XSUB(j)  (1280 + 64 * (j))
#define XB_XGEN(j)  (2304 + 64 * (j))
#define XB_TOP      3328
#define XB_TOPGEN   3392
#define XCD_BAR_WORDS 3456
#define XB_SPIN_CAP (1u << 18)
__device__ __forceinline__ unsigned xb_ld(unsigned* p)              { return __hip_atomic_load(p, __ATOMIC_RELAXED, __HIP_MEMORY_SCOPE_AGENT); }
__device__ __forceinline__ unsigned xb_add(unsigned* p, unsigned v) { return __hip_atomic_fetch_add(p, v, __ATOMIC_RELAXED, __HIP_MEMORY_SCOPE_AGENT); }
__device__ __forceinline__ unsigned xb_xcc_id() { return (unsigned)__builtin_amdgcn_s_getreg((3 << 11) | 20) & 0xFu; }
#define XB_SPIN(cond, bar) do { unsigned _sp = 0; while (cond) { __builtin_amdgcn_s_sleep(1); \
    if ((++_sp & 255u) == 0u) { if (xb_ld(&(bar)[XB_TMO])) break; if (_sp > XB_SPIN_CAP) { atomicAdd(&(bar)[XB_TMO], 1u); break; } } } } while (0)
struct XcdBarrier { unsigned* bar; unsigned x; volatile LAS unsigned* st; };
__device__ __forceinline__ XcdBarrier xcd_barrier_post(unsigned* bar, volatile LAS unsigned* st) {
    XcdBarrier b; b.bar = bar; b.x = xb_xcc_id(); b.st = st;
    if (threadIdx.x == 0) (void)xb_add(&bar[XB_XCNT(b.x)], 1u);
    return b;
}
__device__ __forceinline__ void xcd_barrier_complete(unsigned* bar, unsigned x, unsigned& nloc, unsigned& nx) {
    const unsigned G = gridDim.x * gridDim.y * gridDim.z;
    unsigned sum, cnt, mine, sp = 0u;
    for (;;) {
        sum = 0u; cnt = 0u; mine = 0u;
#pragma unroll
        for (unsigned j = 0; j < 16; ++j) { const unsigned c = xb_ld(&bar[XB_XCNT(j)]); sum += c; cnt += (c > 0u) ? 1u : 0u; mine = (j == x) ? c : mine; }
        if (sum == G) break;
        __builtin_amdgcn_s_sleep(1);
        if ((++sp & 255u) == 0u) { if (xb_ld(&bar[XB_TMO])) break; if (sp > XB_SPIN_CAP) { atomicAdd(&bar[XB_TMO], 1u); break; } }
    }
    nloc = mine > 0u ? mine : 1u; nx = cnt > 0u ? cnt : 1u;
}
__device__ __forceinline__ void xcd_barrier(const XcdBarrier& b) {
    asm volatile("s_waitcnt vmcnt(0)" ::: "memory");
    __syncthreads();
    if (threadIdx.x == 0) {
        unsigned* bar = b.bar;
        __builtin_amdgcn_s_waitcnt(0);
        unsigned nloc = b.st[0], nx = b.st[1];
        if (nloc == 0u) { xcd_barrier_complete(bar, b.x, nloc, nx); b.st[0] = nloc; b.st[1] = nx; }
        const unsigned old = xb_add(&bar[XB_XSUB(b.x)], 1u);
        const unsigned gen = old / nloc;
        if (old + 1u == (gen + 1u) * nloc) {
            __builtin_amdgcn_fence(__ATOMIC_RELEASE, "agent");
            asm volatile("s_waitcnt vmcnt(0)" ::: "memory");
            const unsigned og = xb_add(&bar[XB_TOP], 1u);
            const unsigned tg = og / nx;
            if (og + 1u == (tg + 1u) * nx) xb_add(&bar[XB_TOPGEN], 1u);
            else XB_SPIN(xb_ld(&bar[XB_TOPGEN]) == tg, bar);
            __builtin_amdgcn_fence(__ATOMIC_ACQUIRE, "agent");
            xb_add(&bar[XB_XGEN(b.x)], 1u);
            asm volatile("s_waitcnt vmcnt(0)" ::: "memory");
        } else {
            XB_SPIN(xb_ld(&bar[XB_XGEN(b.x)]) == gen, bar);
            __builtin_amdgcn_fence(__ATOMIC_ACQUIRE, "agent");
            asm volatile("s_waitcnt vmcnt(0)" ::: "memory");
        }
    }
    __syncthreads();
}

typedef const __attribute__((address_space(4))) Params* KParams;
__device__ __forceinline__ Params load_params() {
    Params q{};
#if defined(__HIP_DEVICE_COMPILE__)
    KParams kp = (KParams)__builtin_amdgcn_kernarg_segment_ptr(); asm volatile("" : "+s"(kp));
#pragma unroll
    for (int i = 0; i < 25; ++i) q.in[i] = kp->in[i];
    q.out = kp->out; q.ws = kp->ws; q.ph_lo = kp->ph_lo; q.ph_hi = kp->ph_hi;
#endif
    return q;
}
__global__ void __launch_bounds__(512, 2) mega_fwd(Params pk) {
    extern __shared__ __attribute__((aligned(16))) unsigned char lds_raw[];
    LAS unsigned char* lds = (LAS unsigned char*)lds_raw;
    cg::grid_group grid = cg::this_grid();
    const int G = gridDim.x, c = blockIdx.x;
#ifndef PHASE_MASK
#define PHASE_MASK 0x3fff
#endif
#define IN(k) (((PHASE_MASK >> (k)) & 1) && pk.ph_lo <= (k) && (k) < pk.ph_hi)
    volatile LAS unsigned* bst = (volatile LAS unsigned*)(lds + LDS_BYTES - 16);
    if (threadIdx.x < 2) bst[threadIdx.x] = 0u;
    __syncthreads();
    const XcdBarrier xbar = xcd_barrier_post((unsigned*)(pk.ws + WS_BAR), bst);
#define SEAM(k) do { if ((k) + 1 < pk.ph_hi) { if ((k) == 12) grid.sync(); else xcd_barrier(xbar); } } while (0)
#ifndef PROBE_PHASE
#define PROBE_PHASE -1
#define PROBE_REPS 1
#endif
#define NREP(k) ((k) == PROBE_PHASE ? PROBE_REPS : 1)
    for (int rep_ = 0; rep_ < NREP(0); ++rep_) if (IN(0)) { const Params p = load_params(); ph_setup(p, lds); SEAM(0); }
    for (int rep_ = 0; rep_ < NREP(1); ++rep_) if (IN(1)) { const Params p = load_params(); ph_hl(p, lds); SEAM(1); }
    for (int rep_ = 0; rep_ < NREP(2); ++rep_) if (IN(2)) { const Params p = load_params(); pg8::Gemm g{(const bf16_t*)(p.ws + WS_HL), (const bf16_t*)(p.ws + WS_WIN), D}; pg8::OrderP S{G, c};
        pg8::EpiP E{(bf16_t*)(p.ws + WS_PD), (bf16_t*)(p.ws + WS_PL), p.in[11], p.in[13]}; pg8::gemm_phase(lds, g, S, E); SEAM(2); }
    for (int rep_ = 0; rep_ < NREP(3); ++rep_) if (IN(3)) { const Params p = load_params(); ph_prep(p, lds); SEAM(3); }
    for (int rep_ = 0; rep_ < NREP(4); ++rep_) if (IN(4)) { const Params p = load_params(); ph_scan2(p, lds); SEAM(4); }
    for (int rep_ = 0; rep_ < NREP(5); ++rep_) if (IN(5)) { const Params p = load_params(); ph_merge(p); SEAM(5); }
    for (int rep_ = 0; rep_ < NREP(6); ++rep_) if (IN(6)) { const Params p = load_params(); pg8::Gemm g{(const bf16_t*)(p.ws + WS_AB), (const bf16_t*)(p.ws + WS_WPAB), 512}; pg8::OrderY S{G, c};
        pg8::EpiY E{(bf16_t*)(p.ws + WS_Y), (const bf16_t*)(p.ws + WS_PL)}; pg8::gemm_phase(lds, g, S, E); SEAM(6); }
    for (int rep_ = 0; rep_ < NREP(8); ++rep_) if (IN(8)) { const Params p = load_params(); pg8::Gemm g{(const bf16_t*)(p.ws + WS_Y), (const bf16_t*)(p.ws + WS_WOUT), D}; pg8::StaticOrder S{NTOK / 256, 4, G, c};
        pg8::EpiBf E{(bf16_t*)(p.ws + WS_YL), D}; pg8::gemm_phase(lds, g, S, E); SEAM(8); }
    for (int rep_ = 0; rep_ < NREP(9); ++rep_) if (IN(9)) { const Params p = load_params(); ph_post(p, lds); SEAM(9); }
    for (int rep_ = 0; rep_ < NREP(10); ++rep_) if (IN(10)) { const Params p = load_params(); ph_scatter(p, lds); __syncthreads(); ph_wexp(p, lds); SEAM(10); }
    for (int rep_ = 0; rep_ < NREP(11); ++rep_) if (IN(11)) { const Params p = load_params();
        LAS int* tab = (LAS int*)(lds + LDS_STAGE); const int* gtab = (const int*)(p.ws + WS_TAB);
        for (int i = otid(); i < 1 + MAXBLK; i += 512) tab[i] = gtab[i];
        __syncthreads();
        pg8::Gemm g{(const bf16_t*)(p.ws + WS_HL), (const bf16_t*)(p.ws + WS_WGU), D}; pg8::OrderMoe<true> S{G, c, 8, tab, (const int*)(p.ws + WS_PTOK)};
        pg8::EpiAct E{(bf16_t*)(p.ws + WS_ACT), p.in[22]}; pg8::gemm_phase(lds, g, S, E); SEAM(11); }
    for (int rep_ = 0; rep_ < NREP(12); ++rep_) if (IN(12)) { const Params p = load_params();
        LAS int* tab = (LAS int*)(lds + LDS_STAGE); const int* gtab = (const int*)(p.ws + WS_TAB);
        for (int i = otid(); i < 1 + MAXBLK; i += 512) tab[i] = gtab[i];
        __syncthreads();
        pg8::Gemm g{(const bf16_t*)(p.ws + WS_ACT), (const bf16_t*)(p.ws + WS_WDN), D}; pg8::OrderMoe<false> S{G, c, 4, tab, nullptr};
        pg8::EpiDown E{(bf16_t*)(p.ws + WS_YB), p.in[24], (const float*)(p.ws + WS_PW)}; pg8::gemm_phase(lds, g, S, E); SEAM(12); }
    for (int rep_ = 0; rep_ < NREP(13); ++rep_) if (IN(13)) { const Params p = load_params(); ph_combine(p); }
#undef IN
#undef SEAM
}

#ifndef N_LAUNCH_MODE
#define N_LAUNCH_MODE 1
#endif

extern "C" void kernel_launch(void* const* d_in, const int* in_sizes, int n_in, void* d_out, int out_size, void* d_ws, size_t ws_size, hipStream_t stream) {
    static int grid_blocks = 0;
    if (grid_blocks == 0) {
        if (n_in != 25 || ws_size < WS_END) { fprintf(stderr, "kernel_launch: unexpected n_in %d or ws_size %zu (< %zu)\n", n_in, ws_size, (size_t)WS_END); grid_blocks = -1; return; }
        int dev = 0, cus = 0, per_cu = 0;
        hipGetDevice(&dev);
        hipDeviceGetAttribute(&cus, hipDeviceAttributeMultiprocessorCount, dev);
        hipFuncSetAttribute((const void*)mega_fwd, hipFuncAttributeMaxDynamicSharedMemorySize, LDS_BYTES);
        hipOccupancyMaxActiveBlocksPerMultiprocessor(&per_cu, (const void*)mega_fwd, 512, LDS_BYTES);
        if (per_cu < 1) { fprintf(stderr, "kernel_launch: occupancy query says %d blocks/CU\n", per_cu); per_cu = 1; }
        if (per_cu > 1) per_cu = 1;
        grid_blocks = cus * per_cu;
    }
    if (grid_blocks < 0) return;
    if (hipMemsetAsync((char*)d_ws + WS_BAR, 0, 16384, stream) != hipSuccess) { fprintf(stderr, "kernel_launch: memset of the barrier words failed\n"); return; }
    Params p{};
    for (int i = 0; i < 25; ++i) p.in[i] = (const float*)d_in[i];
    p.out = (float*)d_out; p.ws = (unsigned char*)d_ws;
#if N_LAUNCH_MODE == 1
    p.ph_lo = 0; p.ph_hi = NPHASE;
    { void* args[] = {&p}; hipError_t e = hipLaunchCooperativeKernel((const void*)mega_fwd, dim3(grid_blocks), dim3(512), args, LDS_BYTES, stream);
      if (e != hipSuccess) fprintf(stderr, "cooperative launch failed: %s (grid %d)\n", hipGetErrorString(e), grid_blocks); }
#else
    for (int ph = 0; ph < NPHASE; ++ph) {
        p.ph_lo = ph; p.ph_hi = ph + 1;
        void* args[] = {&p}; hipError_t e = hipLaunchCooperativeKernel((const void*)mega_fwd, dim3(grid_blocks), dim3(512), args, LDS_BYTES, stream);
        if (e != hipSuccess) { fprintf(stderr, "cooperative launch (phase %d) failed: %s (grid %d)\n", ph, hipGetErrorString(e), grid_blocks); break; }
    }
#endif
}
```

```cpp
#include <hip/hip_runtime.h>
#include <hip/hip_cooperative_groups.h>
#include <cstdio>
namespace cg = cooperative_groups;

#define LAS __attribute__((address_space(3)))
typedef unsigned short bf16_t;
typedef short bf16x8 __attribute__((ext_vector_type(8)));
typedef float f32x4 __attribute__((ext_vector_type(4)));
typedef float f32x2 __attribute__((ext_vector_type(2)));
typedef unsigned u32x4 __attribute__((ext_vector_type(4)));
typedef unsigned u32x2 __attribute__((ext_vector_type(2)));
typedef int i32x4 __attribute__((ext_vector_type(4)));
typedef int i32x8 __attribute__((ext_vector_type(8)));

constexpr int D = 1024, NB = 16, T = 2048, TC = 256;
constexpr int NTOK = NB * T, NCTX = NB * TC, MROWS = NTOK + NCTX;
constexpr int NIN = 6672, NP = 6656;
constexpr int C_MQ = 0, C_MK = 512, C_MV = 1024, C_MO = 1536, C_HQ = 2048, C_HI = 2560, C_HG = 3072, C_HF = 3584, C_GA = 4608, C_GB = 5632, C_MG = 6656;
constexpr int NE = 32, TOPK = 4, PMAX = NTOK * TOPK + NE * 256, MAXBLK = PMAX / 256;
constexpr float EPS = 1e-6f;
constexpr int NPHASE = 14;
constexpr int LDS_STAGE = 131072, LDS_BYTES = LDS_STAGE + 16384;
constexpr float F8_WSCALE = 32.0f, F8_ASCALE = 4.0f;

constexpr size_t al256(size_t x) { return (x + 255) & ~(size_t)255; }
constexpr size_t SZ_T = (size_t)NB * 4 * 128 * 2304 * 2;
constexpr size_t SZ_N = (size_t)NTOK * 512 * 2;
constexpr size_t SZ_ST = (size_t)NB * 4 * 2 * 32 * 128 * 128 * 2;
constexpr int PD_W = 3584, PL_W = 3072;
constexpr int PD_MQ = 0, PD_MK = 512, PD_MV = 1024, PD_HQ = 1536, PD_HI = 2048, PD_HF = 2560;
constexpr int PL_MO = 0, PL_HG = 512, PL_GA = 1024, PL_GB = 2048;
constexpr int NBHD = NB * 4 * 2;
constexpr size_t WS_WIN = 0;
constexpr size_t WS_WPAB = WS_WIN + (size_t)NP * D * 2;
constexpr size_t WS_WOUT = WS_WPAB + (size_t)D * D * 2;
constexpr size_t WS_MOD = WS_WOUT + (size_t)D * D * 2;
constexpr size_t WS_MG = al256(WS_MOD + 17 * 6144 * 4);
constexpr size_t WS_TOPE = al256(WS_MG + (size_t)MROWS * 16 * 4);
constexpr size_t WS_TOPW = WS_TOPE + (size_t)NTOK * 4 * 4;
constexpr size_t WS_DEST = WS_TOPW + (size_t)NTOK * 4 * 4;
constexpr size_t WS_PW = WS_DEST + (size_t)NTOK * 4 * 4;
constexpr size_t WS_PTOK = al256(WS_PW + (size_t)PMAX * 4);
constexpr size_t WS_CNT = al256(WS_PTOK + (size_t)PMAX * 4);
constexpr size_t WS_TAB = WS_CNT + 256 * 32 * 4;
constexpr size_t WS_BAR = WS_TAB + 4096;
constexpr size_t WS_GW = WS_BAR + 16384;
constexpr size_t WS_G1 = WS_GW + (size_t)NBHD * 2304 * 4;
constexpr size_t WS_WB = WS_G1 + (size_t)NBHD * 2304 * 4;
constexpr size_t WS_DEC = WS_WB + (size_t)NBHD * 2304 * 2;
constexpr size_t WS_EAL = al256(WS_DEC + (size_t)NBHD * 36 * 4);
constexpr size_t WS_NS = WS_EAL + (size_t)NBHD * 36 * 128 * 4;
constexpr size_t WS_HL = al256(WS_NS + (size_t)NBHD * 32 * 128 * 4);
constexpr size_t WS_QK = WS_HL;
constexpr size_t WS_RW = WS_HL + (size_t)MROWS * D * 2;
constexpr size_t WS_WGU = WS_RW;
constexpr size_t WS_WDN = WS_WGU + (size_t)NE * 2048 * D * 2;
constexpr size_t WS_KEFN = WS_RW, WS_KEBN = WS_RW + SZ_N, WS_QPFN = WS_RW + 2 * SZ_N, WS_QPBN = WS_RW + 3 * SZ_N;
constexpr size_t WS_AB = WS_RW + 4 * SZ_N;
constexpr size_t WS_RPD = WS_WDN + (size_t)NE * D * D * 2;
constexpr size_t WS_PD = WS_RPD;
constexpr size_t WS_HS = WS_RPD;
constexpr size_t WS_YL = WS_RPD;
constexpr size_t WS_RT = WS_RPD + 2 * SZ_ST;
constexpr size_t WS_KT = WS_RT, WS_VTF = WS_RT + SZ_T, WS_VTB = WS_RT + 2 * SZ_T, WS_KEFT = WS_RT + 3 * SZ_T, WS_KEBT = WS_RT + 4 * SZ_T, WS_IT = WS_RT + 5 * SZ_T;
constexpr size_t WS_Y = WS_RT;
constexpr size_t WS_RPL = WS_RT + 6 * SZ_T;
constexpr size_t WS_PL = WS_RPL;
constexpr size_t WS_XB = WS_RPD;
constexpr size_t WS_ACT = WS_XB + (size_t)PMAX * D * 2;
constexpr size_t WS_YB = WS_XB;
constexpr size_t WS_X1B = WS_ACT + (size_t)PMAX * D * 2;
constexpr size_t WS_END1 = WS_RPL + (size_t)NTOK * PL_W * 2;
constexpr size_t WS_END2 = WS_X1B + (size_t)NTOK * D * 2;
constexpr size_t WS_END = WS_END1 > WS_END2 ? WS_END1 : WS_END2;
static_assert((size_t)MROWS * PD_W * 2 <= 2 * SZ_ST, "P_dead must fit its region");
static_assert(WS_AB + (size_t)NTOK * D * 2 <= WS_RPD, "AB must fit the expert-weight region");
static_assert(WS_END <= (size_t)4 * 268435456, "workspace too large");

struct Params { const float* in[25]; float* out; unsigned char* ws; int ph_lo, ph_hi; };

__device__ __forceinline__ int otid() { int t = threadIdx.x; asm volatile("" : "+v"(t)); return t; }
__device__ __forceinline__ unsigned cvt_pk_bf16(float lo, float hi) { unsigned r; asm volatile("v_cvt_pk_bf16_f32 %0, %1, %2" : "=v"(r) : "v"(lo), "v"(hi)); return r; }
__device__ __forceinline__ unsigned pk_fp8x4(float a, float b, float c, float d) {
    unsigned w; asm volatile("v_cvt_pk_fp8_f32 %0, %1, %2" : "=v"(w) : "v"(a), "v"(b)); asm volatile("v_cvt_pk_fp8_f32 %0, %1, %2 op_sel:[0,0,1]" : "+v"(w) : "v"(c), "v"(d)); return w; }
__device__ __forceinline__ float bf_lo(unsigned w) { return __uint_as_float(w << 16); }
__device__ __forceinline__ float bf_hi(unsigned w) { return __uint_as_float(w & 0xffff0000u); }
__device__ __forceinline__ float sigmoidf_(float x) { return __builtin_amdgcn_rcpf(1.0f + __builtin_amdgcn_exp2f(-1.4426950408889634f * x)); }
__device__ __forceinline__ float siluf_(float x) { return x * __builtin_amdgcn_rcpf(1.0f + __builtin_amdgcn_exp2f(-1.4426950408889634f * x)); }
__device__ __forceinline__ float wave_sum(float v) {
#pragma unroll
    for (int o = 1; o < 64; o <<= 1) v += __shfl_xor(v, o);
    return v;
}
__device__ __forceinline__ void unpack8(const u32x4 w, float (&f)[8]) {
    f[0] = bf_lo(w.x); f[1] = bf_hi(w.x); f[2] = bf_lo(w.y); f[3] = bf_hi(w.y); f[4] = bf_lo(w.z); f[5] = bf_hi(w.z); f[6] = bf_lo(w.w); f[7] = bf_hi(w.w);
}
__device__ __forceinline__ u32x4 pack8(const float (&f)[8]) {
    u32x4 w; w.x = cvt_pk_bf16(f[0], f[1]); w.y = cvt_pk_bf16(f[2], f[3]); w.z = cvt_pk_bf16(f[4], f[5]); w.w = cvt_pk_bf16(f[6], f[7]); return w;
}

namespace pg8 {
constexpr int BM = 256, BK = 64, HALF = 128, HTB = HALF * BK * 2, STAGE_BYTES = 8 * HTB, NXCD = 8, WGM = 8;
__device__ __forceinline__ int lds_byte(int r, int c) { const int st = (r >> 4) * 2 + (c >> 5), rr = r & 15, cc = c & 31, ob = rr * 64 + cc * 2; return st * 1024 + (ob ^ (((ob >> 9) & 1) << 5)); }
__device__ __forceinline__ void stage_rc(int b, int& R, int& C) { const int st = b / 1024, sb = b % 1024, swz = sb ^ (((sb >> 9) & 1) << 5); R = (st >> 1) * 16 + swz / 64; C = (st & 1) * 32 + (swz % 64) / 2; }
__device__ __forceinline__ int perm32(int rho) { const int n = rho >> 4, i = rho & 15; return 8 * (i >> 2) + 4 * n + (i & 3); }

struct Unit { int pm, pn, pb, e, pa; };
struct Gemm { const bf16_t* A; const bf16_t* Bt; int K; };

__device__ __forceinline__ void static_map(int wgid, int nM, int nN, int& pm, int& pn) {
    const int nwg = nM * nN;
    { const int q = nwg / NXCD, r = nwg % NXCD, xcd = wgid % NXCD, off = wgid / NXCD; wgid = (xcd < r ? xcd * (q + 1) : r * (q + 1) + (xcd - r) * q) + off; }
    const int nig = WGM * nN, gid = wgid / nig, fm = gid * WGM, gsz = (nM - fm) < WGM ? (nM - fm) : WGM;
    pm = fm + ((wgid % nig) % gsz); pn = (wgid % nig) / gsz;
}
struct StaticOrder {
    static constexpr bool GATHER = false;
    int nM, nN, G, c;
    __device__ __forceinline__ bool next(int i, Unit& u) const {
        const int L = i * G + c; if (L >= nM * nN) return false;
        static_map(L, nM, nN, u.pm, u.pn); u.pb = u.pn; u.e = 0; u.pa = u.pm; return true;
    }
};
struct OrderP {
    static constexpr bool GATHER = false;
    int G, c;
    __device__ __forceinline__ bool next(int i, Unit& u) const {
        const int L = i * G + c;
        if (L < 128 * 26) { static_map(L, 128, 26, u.pm, u.pn); }
        else { const int r = L - 128 * 26; if (r >= 160) return false; const int q = r >> 4; u.pm = 128 + (r & 15); u.pn = q < 4 ? 2 + q : (q < 6 ? 6 + q : 8 + q); }
        u.pb = u.pn; u.e = 0; u.pa = u.pm; return true;
    }
};
struct OrderY {
    static constexpr bool GATHER = false;
    int G, c;
    __device__ __forceinline__ bool next(int i, Unit& u) const {
        const int L = (i >> 1) * G + c, which = i & 1; if (L >= (NTOK / 256) * 4) return false;
        static_map(L, NTOK / 256, 4, u.pm, u.pn); u.pa = u.pm + which * (NTOK / 256); u.pb = u.pn + which * 4; u.e = which; return true;
    }
};
template <bool GATHER_> struct OrderMoe {
    static constexpr bool GATHER = GATHER_;
    int G, c, nN; const LAS int* tab; const int* rowidx;
    __device__ __forceinline__ bool next(int i, Unit& u) const {
        int pm, pn;
        if ((G & 7) == 0 && G >= 64) { const int ppx = (G >> 3) / nN, j = c >> 3; pm = i * (8 * ppx) + (c & 7) * ppx + j / nN; pn = j % nN; }
        else { const int L = i * G + c; pm = L / nN; pn = L - pm * nN; }
        const int nblk = __builtin_amdgcn_readfirstlane(tab[0]);
        if (pm >= nblk) return false;
        const int e = __builtin_amdgcn_readfirstlane(tab[1 + pm]);
        u.pm = pm; u.pn = pn; u.pb = e * nN + pn; u.e = e; u.pa = pm; return true;
    }
};

template <class Epi, class Sched>
__device__ __forceinline__ void gemm_phase(LAS unsigned char* lds, const Gemm g, const Sched& S, const Epi& E) {
    const int tid = otid(), wid = __builtin_amdgcn_readfirstlane(tid >> 6), lane = tid & 63, wr = wid >> 2, wc = wid & 3, fr = lane & 15, fq = lane >> 4;
    const int K = g.K, nt = K / BK;
    unsigned voffB[2], vc[2][2], vn[2][2]; int Ra[2], Cb[2];
#pragma unroll
    for (int i = 0; i < 2; ++i) { int R, C; stage_rc(tid * 16 + i * 8192, R, C); const int Rb = Epi::PERM ? ((R & ~31) + perm32(R & 31)) : R;
        Ra[i] = R; Cb[i] = C * 2; voffB[i] = (unsigned)(Rb * K + C) * 2u; vc[0][i] = vc[1][i] = vn[0][i] = vn[1][i] = (unsigned)(R * K + C) * 2u; }
    LAS int* gidx = (LAS int*)(lds + STAGE_BYTES + 4096);
    LAS unsigned char* ebase = lds + STAGE_BYTES + 6144;
    const size_t kstep = (size_t)(BK * 2);
    const size_t hstep = (size_t)HALF * K * 2;
    const size_t tstep = 2 * hstep;
    const size_t hsA = Sched::GATHER ? 0 : hstep;
    const unsigned ldsw = (unsigned)wid * 1024u;
    const int aoff = lds_byte(wr * 64 + fr, fq * 8), boff = lds_byte(wc * 32 + fr, fq * 8);
#define PG8_SA(b, h) (((b) * 2 + (h)) * HTB)
#define PG8_SB(b, h) ((4 + (b) * 2 + (h)) * HTB)
#define PG8_STAGE(bufoff, gbase, voff) do { _Pragma("unroll") for (int _i = 0; _i < 2; ++_i) { unsigned _vo = (voff)[_i]; asm volatile("" : "+v"(_vo)); \
        __builtin_amdgcn_global_load_lds((const unsigned*)((const char*)(gbase) + _vo), (LAS unsigned*)(lds + (bufoff) + ldsw + _i * 8192), 16, 0, 0); } } while (0)
#define PG8_LDA(dst, b, h) do { _Pragma("unroll") for (int m = 0; m < 4; ++m) _Pragma("unroll") for (int k = 0; k < 2; ++k) dst[m][k] = *(const LAS bf16x8*)(lds + PG8_SA(b, h) + aoff + m * 2048 + k * 1024); } while (0)
#define PG8_LDB(dst, b, h) do { _Pragma("unroll") for (int n = 0; n < 2; ++n) _Pragma("unroll") for (int k = 0; k < 2; ++k) dst[n][k] = *(const LAS bf16x8*)(lds + PG8_SB(b, h) + boff + n * 2048 + k * 1024); } while (0)
#define PG8_CAT8(x) __builtin_shufflevector((i32x4)(x)[0], (i32x4)(x)[1], 0, 1, 2, 3, 4, 5, 6, 7)
#define PG8_MMA8(ai, bj, A_, B_, m, n) asm volatile("v_mfma_f32_16x16x128_f8f6f4 %0, %1, %2, %0" : "+v"(acc[ai][bj][m][n]) : "v"(PG8_CAT8(B_[n])), "v"(PG8_CAT8(A_[m])))
#define PG8_MMA_DRAIN asm volatile("s_nop 15\n\ts_nop 15" ::: "memory")
#define PG8_MMA(ai, bj, At, Bt) do { __builtin_amdgcn_s_setprio(1); \
        if constexpr (Epi::FP8) { _Pragma("unroll") for (int m = 0; m < 4; ++m) _Pragma("unroll") for (int n = 0; n < 2; ++n) PG8_MMA8(ai, bj, At, Bt, m, n); } \
        else { _Pragma("unroll") for (int m = 0; m < 4; ++m) _Pragma("unroll") for (int n = 0; n < 2; ++n) _Pragma("unroll") for (int k = 0; k < 2; ++k) \
            acc[ai][bj][m][n] = __builtin_amdgcn_mfma_f32_16x16x32_bf16(Bt[n][k], At[m][k], acc[ai][bj][m][n], 0, 0, 0); } \
        __builtin_amdgcn_s_setprio(0); } while (0)
#define PG8_WAIT_V(n) asm volatile("s_waitcnt vmcnt(" #n ")" ::: "memory")
#define PG8_WAIT_L(n) asm volatile("s_waitcnt lgkmcnt(" #n ")" ::: "memory")
#define PG8_BAR __builtin_amdgcn_s_barrier()
#define PG8_SCHED __builtin_amdgcn_sched_barrier(0)
    Unit cur, nxt; int ui = 0;
    if (!S.next(0, cur)) return;
    f32x4 acc[2][2][4][2];
#pragma unroll
    for (int a = 0; a < 2; ++a)
#pragma unroll
        for (int b = 0; b < 2; ++b)
#pragma unroll
            for (int m = 0; m < 4; ++m)
#pragma unroll
                for (int n = 0; n < 2; ++n) acc[a][b][m][n] = (f32x4){0.f, 0.f, 0.f, 0.f};
    bf16x8 At[4][2], B0[2][2], B1[2][2];
    const char* cA = Sched::GATHER ? (const char*)g.A : (const char*)g.A + (size_t)cur.pa * tstep; const char* cB = (const char*)g.Bt + (size_t)cur.pb * tstep;
    if constexpr (Sched::GATHER) {
        if (wid == 0) __builtin_amdgcn_global_load_lds((const unsigned*)(S.rowidx + (size_t)cur.pm * 256 + 4 * lane), (LAS unsigned*)gidx, 16, 0, 0);
        asm volatile("s_waitcnt vmcnt(0)" ::: "memory"); __syncthreads();
#pragma unroll
        for (int h = 0; h < 2; ++h)
#pragma unroll
            for (int i = 0; i < 2; ++i) { vc[h][i] = (unsigned)gidx[h * 128 + Ra[i]] * (unsigned)(K * 2) + (unsigned)Cb[i]; vn[h][i] = vc[h][i]; }
    }
    PG8_STAGE(PG8_SB(0, 0), cB, voffB); PG8_STAGE(PG8_SA(0, 0), cA, vc[0]); PG8_STAGE(PG8_SB(0, 1), cB + hstep, voffB); PG8_STAGE(PG8_SA(0, 1), cA + hsA, vc[1]);
    if (wr == 1) PG8_BAR;
    PG8_WAIT_V(4); PG8_BAR;
    PG8_STAGE(PG8_SB(1, 0), cB + kstep, voffB); PG8_STAGE(PG8_SA(1, 0), cA + kstep, vc[0]); PG8_STAGE(PG8_SB(1, 1), cB + hstep + kstep, voffB);
    PG8_WAIT_V(6); PG8_BAR;
    for (;;) {
        const bool has_next = S.next(ui + 1, nxt);
        E.prefetch(cur, ebase + (ui & 1) * 3072, wid, lane);
        const char* nA = Sched::GATHER ? cA : (has_next ? (const char*)g.A + (size_t)nxt.pa * tstep : cA); const char* nB = has_next ? (const char*)g.Bt + (size_t)nxt.pb * tstep : cB;
        if constexpr (Sched::GATHER) { if (has_next && wid == 0) __builtin_amdgcn_global_load_lds((const unsigned*)(S.rowidx + (size_t)nxt.pm * 256 + 4 * lane), (LAS unsigned*)(gidx + ((ui + 1) & 1) * 256), 16, 0, 0); }
        for (int t = 0; t < nt; t += 2) {
            const bool last = (t == nt - 2);
            const char* a1 = cA + (size_t)(t + 1) * kstep;
            const char* a2 = last ? nA : cA + (size_t)(t + 2) * kstep; const char* b2 = last ? nB : cB + (size_t)(t + 2) * kstep;
            const char* a3 = a2 + kstep; const char* b3 = b2 + kstep;
            if constexpr (Sched::GATHER) { if (last && has_next) {
#pragma unroll
                for (int h = 0; h < 2; ++h)
#pragma unroll
                    for (int i = 0; i < 2; ++i) vn[h][i] = (unsigned)gidx[((ui + 1) & 1) * 256 + h * 128 + Ra[i]] * (unsigned)(K * 2) + (unsigned)Cb[i]; } }
            unsigned w2[2][2];
#pragma unroll
            for (int h = 0; h < 2; ++h)
#pragma unroll
                for (int i = 0; i < 2; ++i) w2[h][i] = last ? vn[h][i] : vc[h][i];
            PG8_LDB(B0, 0, 0); PG8_SCHED; PG8_LDA(At, 0, 0); PG8_STAGE(PG8_SA(1, 1), a1 + hsA, vc[1]);
            PG8_WAIT_L(8); PG8_BAR; PG8_WAIT_L(0); PG8_MMA(0, 0, At, B0); PG8_BAR; PG8_SCHED;
            PG8_LDB(B1, 0, 1); PG8_STAGE(PG8_SB(0, 0), b2, voffB);
            PG8_BAR; PG8_WAIT_L(0); PG8_MMA(0, 1, At, B1); PG8_BAR;
            PG8_LDA(At, 0, 1); PG8_STAGE(PG8_SA(0, 0), a2, w2[0]);
            PG8_BAR; PG8_WAIT_L(0); PG8_MMA(1, 0, At, B0); PG8_BAR; PG8_SCHED;
            PG8_STAGE(PG8_SB(0, 1), b2 + hstep, voffB);
            PG8_WAIT_V(6); PG8_BAR; PG8_MMA(1, 1, At, B1); PG8_BAR;
            PG8_LDB(B0, 1, 0); PG8_SCHED; PG8_LDA(At, 1, 0); PG8_STAGE(PG8_SA(0, 1), a2 + hsA, w2[1]);
            PG8_WAIT_L(8); PG8_BAR; PG8_WAIT_L(0); PG8_MMA(0, 0, At, B0); PG8_BAR; PG8_SCHED;
            PG8_LDB(B1, 1, 1); PG8_STAGE(PG8_SB(1, 0), b3, voffB);
            PG8_BAR; PG8_WAIT_L(0); PG8_MMA(0, 1, At, B1); PG8_BAR;
            PG8_LDA(At, 1, 1); PG8_STAGE(PG8_SA(1, 0), a3, w2[0]);
            PG8_BAR; PG8_WAIT_L(0); PG8_MMA(1, 0, At, B0); PG8_BAR; PG8_SCHED;
            PG8_STAGE(PG8_SB(1, 1), b3 + hstep, voffB);
            PG8_WAIT_V(6); PG8_BAR; PG8_MMA(1, 1, At, B1); PG8_BAR;
        }
        if constexpr (Epi::FP8) PG8_MMA_DRAIN;
        bool carry = false;
        if constexpr (Epi::CARRY) { carry = E.first_pass(cur); if (carry) E.rescale(acc, cur, wr, wc, fr, fq); }
        if (!carry) E(acc, cur, wr, wc, fr, fq, ebase + (ui & 1) * 3072);
        if (!has_next) break;
        if (!carry) {
#pragma unroll
        for (int a = 0; a < 2; ++a)
#pragma unroll
            for (int b = 0; b < 2; ++b)
#pragma unroll
                for (int m = 0; m < 4; ++m)
#pragma unroll
                    for (int n = 0; n < 2; ++n) acc[a][b][m][n] = (f32x4){0.f, 0.f, 0.f, 0.f};
        }
        cur = nxt; cA = nA; cB = nB; ++ui;
#pragma unroll
        for (int h = 0; h < 2; ++h)
#pragma unroll
            for (int i = 0; i < 2; ++i) vc[h][i] = vn[h][i];
    }
    PG8_WAIT_V(0);
    if (wr == 0) PG8_BAR;
    PG8_BAR;
#undef PG8_SA
#undef PG8_SB
#undef PG8_STAGE
#undef PG8_LDA
#undef PG8_LDB
#undef PG8_MMA
#undef PG8_CAT8
#undef PG8_MMA8
#undef PG8_MMA_DRAIN
#undef PG8_WAIT_V
#undef PG8_WAIT_L
#undef PG8_BAR
#undef PG8_SCHED
}

struct EpiF32 {
    static constexpr bool PERM = false, MID = false, CARRY = false, FP8 = false;
    float* C; int ldc;
    __device__ __forceinline__ void prefetch(const Unit&, LAS unsigned char*, int, int) const {}
    __device__ __forceinline__ void operator()(const f32x4 (&acc)[2][2][4][2], const Unit& u, int wr, int wc, int fr, int fq, const LAS unsigned char*) const {
        const int row0 = u.pm * BM + wr * 64 + fr, col0 = u.pn * BM + wc * 32 + 4 * fq;
#pragma unroll
        for (int ai = 0; ai < 2; ++ai)
#pragma unroll
            for (int m = 0; m < 4; ++m) { float* rowp = C + (size_t)(row0 + ai * HALF + m * 16) * ldc + col0;
#pragma unroll
                for (int bj = 0; bj < 2; ++bj)
#pragma unroll
                    for (int n = 0; n < 2; ++n) *(f32x4*)(rowp + bj * HALF + n * 16) = acc[ai][bj][m][n]; }
    }
};
struct EpiBf {
    static constexpr bool PERM = true, MID = false, CARRY = false, FP8 = false;
    bf16_t* C; int ldc;
    __device__ __forceinline__ void prefetch(const Unit&, LAS unsigned char*, int, int) const {}
    __device__ __forceinline__ void operator()(const f32x4 (&acc)[2][2][4][2], const Unit& u, int wr, int wc, int fr, int fq, const LAS unsigned char*) const {
        const int row0 = u.pm * BM + wr * 64 + fr, col0 = u.pn * BM + wc * 32 + 8 * fq;
#pragma unroll
        for (int ai = 0; ai < 2; ++ai)
#pragma unroll
            for (int m = 0; m < 4; ++m) { bf16_t* rowp = C + (size_t)(row0 + ai * HALF + m * 16) * ldc + col0;
#pragma unroll
                for (int bj = 0; bj < 2; ++bj) { const f32x4 v0 = acc[ai][bj][m][0], v1 = acc[ai][bj][m][1];
                    u32x4 w; w.x = cvt_pk_bf16(v0[0], v0[1]); w.y = cvt_pk_bf16(v0[2], v0[3]); w.z = cvt_pk_bf16(v1[0], v1[1]); w.w = cvt_pk_bf16(v1[2], v1[3]);
                    *(u32x4*)(rowp + bj * HALF) = w; } }
    }
};
struct EpiP {
    static constexpr bool PERM = true, MID = false, CARRY = false, FP8 = false;
    bf16_t* PD; bf16_t* PL; const float* b_in; const float* lb_raw;
    __device__ __forceinline__ void prefetch(const Unit& u, LAS unsigned char* eb, int wid, int lane) const {
        if (wid == 0) __builtin_amdgcn_global_load_lds((const unsigned*)(b_in + u.pn * 256 + 4 * lane), (LAS unsigned*)eb, 16, 0, 0);
        if (u.pn >= 14 && u.pn < 18 && (wid == 1 || wid == 2))
            __builtin_amdgcn_global_load_lds((const unsigned*)(lb_raw + (wid - 1) * 1024 + (u.pn * 256 - C_HF) + 4 * lane), (LAS unsigned*)(eb + wid * 1024), 16, 0, 0);
    }
    __device__ __forceinline__ void operator()(const f32x4 (&acc)[2][2][4][2], const Unit& u, int wr, int wc, int fr, int fq, const LAS unsigned char* eb) const {
        const int pn = u.pn;
        bf16_t* base; int ldw, dcol;
        if (pn < 6) { base = PD; ldw = PD_W; dcol = pn * 256; }
        else if (pn < 8) { base = PL; ldw = PL_W; dcol = PL_MO + (pn - 6) * 256; }
        else if (pn < 12) { base = PD; ldw = PD_W; dcol = PD_HQ + (pn - 8) * 256; }
        else if (pn < 14) { base = PL; ldw = PL_W; dcol = PL_HG + (pn - 12) * 256; }
        else if (pn < 18) { base = PD; ldw = PD_W; dcol = PD_HF + (pn - 14) * 256; }
        else { base = PL; ldw = PL_W; dcol = PL_GA + (pn - 18) * 256; }
        const int row0 = u.pm * BM + wr * 64 + fr, col0 = pn * BM + wc * 32 + 8 * fq, ocol = dcol + wc * 32 + 8 * fq;
        const int kind = (pn >= 6 && pn < 8) ? 1 : ((pn >= 8 && pn < 10) || (pn >= 12 && pn < 14)) ? 2 : (pn >= 14 && pn < 18) ? 3 : (pn >= 18) ? 1 : 0;
        f32x4 bv[2][2], lbv[2][2];
#pragma unroll
        for (int bj = 0; bj < 2; ++bj)
#pragma unroll
            for (int n = 0; n < 2; ++n) {
                const int cl = (wc * 32 + 8 * fq + bj * HALF + 4 * n) * 4;
                bv[bj][n] = *(const LAS f32x4*)(eb + cl);
                lbv[bj][n] = (f32x4){0.f, 0.f, 0.f, 0.f};
                if (kind == 3) { const f32x4 r0 = *(const LAS f32x4*)(eb + 1024 + cl), r1 = *(const LAS f32x4*)(eb + 2048 + cl);
#pragma unroll
                    for (int j = 0; j < 4; ++j) lbv[bj][n][j] = 1.0f - 1.0f / (1.0f + __expf(r1[j] - r0[j])); }
            }
#pragma unroll
        for (int ai = 0; ai < 2; ++ai)
#pragma unroll
            for (int m = 0; m < 4; ++m) { bf16_t* rowp = base + (size_t)(row0 + ai * HALF + m * 16) * ldw + ocol;
#pragma unroll
                for (int bj = 0; bj < 2; ++bj) { f32x4 v0 = acc[ai][bj][m][0] + bv[bj][0], v1 = acc[ai][bj][m][1] + bv[bj][1];
                    if (kind == 1) {
#pragma unroll
                        for (int j = 0; j < 4; ++j) { v0[j] = sigmoidf_(v0[j]); v1[j] = sigmoidf_(v1[j]); } }
                    else if (kind == 2) {
#pragma unroll
                        for (int j = 0; j < 4; ++j) { v0[j] = siluf_(v0[j]); v1[j] = siluf_(v1[j]); } }
                    else if (kind == 3) {
#pragma unroll
                        for (int j = 0; j < 4; ++j) { v0[j] = lbv[bj][0][j] * __builtin_amdgcn_rcpf(1.0f + __builtin_amdgcn_exp2f(1.4426950408889634f * v0[j])); v1[j] = lbv[bj][1][j] * __builtin_amdgcn_rcpf(1.0f + __builtin_amdgcn_exp2f(1.4426950408889634f * v1[j])); } }
                    u32x4 w; w.x = cvt_pk_bf16(v0[0], v0[1]); w.y = cvt_pk_bf16(v0[2], v0[3]); w.z = cvt_pk_bf16(v1[0], v1[1]); w.w = cvt_pk_bf16(v1[2], v1[3]);
                    *(u32x4*)(rowp + bj * HALF) = w; } }
    }
};
struct EpiY {
    static constexpr bool PERM = true, MID = false, CARRY = true, FP8 = false;
    bf16_t* Y; const bf16_t* P;
    __device__ __forceinline__ void prefetch(const Unit&, LAS unsigned char*, int, int) const {}
    __device__ __forceinline__ bool first_pass(const Unit& u) const { return u.e == 0; }
    __device__ __forceinline__ void rescale(f32x4 (&acc)[2][2][4][2], const Unit& u, int wr, int wc, int fr, int fq) const {
        const int row0 = u.pm * BM + wr * 64 + fr, col0 = u.pn * BM + wc * 32 + 8 * fq;
#pragma unroll
        for (int ai = 0; ai < 2; ++ai)
#pragma unroll
            for (int mh = 0; mh < 2; ++mh) {
                u32x4 ga[2][2], gb[2][2];
#pragma unroll
                for (int m2 = 0; m2 < 2; ++m2) { const size_t r = (size_t)(row0 + ai * HALF + (2 * mh + m2) * 16);
#pragma unroll
                    for (int bj = 0; bj < 2; ++bj) { ga[m2][bj] = *(const u32x4*)(P + r * PL_W + PL_GA + col0 + bj * HALF); gb[m2][bj] = *(const u32x4*)(P + r * PL_W + PL_GB + col0 + bj * HALF); } }
#pragma unroll
                for (int m2 = 0; m2 < 2; ++m2)
#pragma unroll
                    for (int bj = 0; bj < 2; ++bj) { float a[8], b[8]; unpack8(ga[m2][bj], a); unpack8(gb[m2][bj], b);
#pragma unroll
                        for (int j = 0; j < 4; ++j) { acc[ai][bj][2 * mh + m2][0][j] *= a[j] * __builtin_amdgcn_rcpf(b[j]); acc[ai][bj][2 * mh + m2][1][j] *= a[4 + j] * __builtin_amdgcn_rcpf(b[4 + j]); } }
                asm volatile("" ::: "memory");
            }
    }
    __device__ __forceinline__ void operator()(const f32x4 (&acc)[2][2][4][2], const Unit& u, int wr, int wc, int fr, int fq, const LAS unsigned char*) const {
        const int row0 = u.pm * BM + wr * 64 + fr, col0 = u.pn * BM + wc * 32 + 8 * fq;
#pragma unroll
        for (int ai = 0; ai < 2; ++ai) {
            u32x4 gg[4][2];
#pragma unroll
            for (int m = 0; m < 4; ++m) { const size_t r = (size_t)(row0 + ai * HALF + m * 16);
#pragma unroll
                for (int bj = 0; bj < 2; ++bj) gg[m][bj] = *(const u32x4*)(P + r * PL_W + PL_GB + col0 + bj * HALF); }
#pragma unroll
            for (int m = 0; m < 4; ++m) { const size_t r = (size_t)(row0 + ai * HALF + m * 16);
#pragma unroll
                for (int bj = 0; bj < 2; ++bj) { float b[8], o[8]; unpack8(gg[m][bj], b); const f32x4 v0 = acc[ai][bj][m][0], v1 = acc[ai][bj][m][1];
#pragma unroll
                    for (int j = 0; j < 4; ++j) { o[j] = v0[j] * b[j]; o[4 + j] = v1[j] * b[4 + j]; }
                    *(u32x4*)(Y + r * D + col0 + bj * HALF) = pack8(o); } }
            asm volatile("" ::: "memory");
        }
    }
};
struct EpiAct {
    static constexpr bool PERM = true, MID = false, CARRY = false, FP8 = true;
    unsigned char* ACT; const float* b_gu;
    __device__ __forceinline__ void prefetch(const Unit& u, LAS unsigned char* eb, int wid, int lane) const {
        if (wid == 0) __builtin_amdgcn_global_load_lds((const unsigned*)(b_gu + (size_t)u.e * 2048 + (lane >> 5) * 1024 + u.pn * 128 + 4 * (lane & 31)), (LAS unsigned*)eb, 16, 0, 0);
    }
    __device__ __forceinline__ void operator()(const f32x4 (&acc)[2][2][4][2], const Unit& u, int wr, int wc, int fr, int fq, const LAS unsigned char* eb) const {
        const int row0 = u.pm * BM + wr * 64 + fr, col0 = u.pn * HALF + wc * 32 + 8 * fq;
        const LAS unsigned char* bg = eb + (wc * 32 + 8 * fq) * 4;
        const f32x4 bg0 = *(const LAS f32x4*)(bg), bg1 = *(const LAS f32x4*)(bg + 16), bu0 = *(const LAS f32x4*)(bg + 512), bu1 = *(const LAS f32x4*)(bg + 528);
#pragma unroll
        for (int ai = 0; ai < 2; ++ai)
#pragma unroll
            for (int m = 0; m < 4; ++m) {
                const f32x4 g0 = acc[ai][0][m][0] * (1.0f / F8_WSCALE) + bg0, g1 = acc[ai][0][m][1] * (1.0f / F8_WSCALE) + bg1, u0 = acc[ai][1][m][0] * (1.0f / F8_WSCALE) + bu0, u1 = acc[ai][1][m][1] * (1.0f / F8_WSCALE) + bu1;
                float o[8];
#pragma unroll
                for (int j = 0; j < 4; ++j) {
                    { const float g = fminf(g0[j], 7.0f), up = fminf(fmaxf(u0[j], -7.0f), 7.0f); o[j] = (F8_ASCALE * (up + 1.0f)) * g * __builtin_amdgcn_rcpf(1.0f + __builtin_amdgcn_exp2f(-2.4554669595930156f * g)); }
                    { const float g = fminf(g1[j], 7.0f), up = fminf(fmaxf(u1[j], -7.0f), 7.0f); o[4 + j] = (F8_ASCALE * (up + 1.0f)) * g * __builtin_amdgcn_rcpf(1.0f + __builtin_amdgcn_exp2f(-2.4554669595930156f * g)); } }
                u32x2 w; w.x = pk_fp8x4(o[0], o[1], o[2], o[3]); w.y = pk_fp8x4(o[4], o[5], o[6], o[7]);
                *(u32x2*)(ACT + (size_t)(row0 + ai * HALF + m * 16) * D + col0) = w; }
    }
};
struct EpiDown {
    static constexpr bool PERM = true, MID = false, CARRY = false, FP8 = true;
    bf16_t* YB; const float* b_dn; const float* pw;
    __device__ __forceinline__ void prefetch(const Unit& u, LAS unsigned char* eb, int wid, int lane) const {
        if (wid == 0) __builtin_amdgcn_global_load_lds((const unsigned*)(b_dn + (size_t)u.e * D + u.pn * 256 + 4 * lane), (LAS unsigned*)eb, 16, 0, 0);
        if (wid == 1) __builtin_amdgcn_global_load_lds((const unsigned*)(pw + (size_t)u.pm * 256 + 4 * lane), (LAS unsigned*)(eb + 1024), 16, 0, 0);
    }
    __device__ __forceinline__ void operator()(const f32x4 (&acc)[2][2][4][2], const Unit& u, int wr, int wc, int fr, int fq, const LAS unsigned char* eb) const {
        const int row0 = u.pm * BM + wr * 64 + fr, col0 = u.pn * BM + wc * 32 + 8 * fq;
        f32x4 bv[2][2];
#pragma unroll
        for (int bj = 0; bj < 2; ++bj)
#pragma unroll
            for (int n = 0; n < 2; ++n) bv[bj][n] = *(const LAS f32x4*)(eb + (wc * 32 + 8 * fq + bj * HALF + 4 * n) * 4);
#pragma unroll
        for (int ai = 0; ai < 2; ++ai)
#pragma unroll
            for (int m = 0; m < 4; ++m) { const size_t r = (size_t)(row0 + ai * HALF + m * 16); const float w = *(const LAS float*)(eb + 1024 + (wr * 64 + fr + ai * HALF + m * 16) * 4);
#pragma unroll
                for (int bj = 0; bj < 2; ++bj) { const f32x4 v0 = (acc[ai][bj][m][0] * (1.0f / (F8_WSCALE * F8_ASCALE)) + bv[bj][0]) * w, v1 = (acc[ai][bj][m][1] * (1.0f / (F8_WSCALE * F8_ASCALE)) + bv[bj][1]) * w;
                    u32x4 o; o.x = cvt_pk_bf16(v0[0], v0[1]); o.y = cvt_pk_bf16(v0[2], v0[3]); o.z = cvt_pk_bf16(v1[0], v1[1]); o.w = cvt_pk_bf16(v1[2], v1[3]);
                    *(u32x4*)(YB + r * D + col0 + bj * HALF) = o; } }
    }
};
}

struct WItem { const float* src; bf16_t* dst; int ld, ldd; };
__device__ __forceinline__ void witem_load(const WItem& w, f32x4 (&v)[16], int lane) {
#pragma unroll
    for (int i = 0; i < 16; ++i) v[i] = __builtin_nontemporal_load((const f32x4*)(w.src + (size_t)(8 * i + (lane >> 3)) * w.ld + (lane & 7) * 4));
}
template <bool F8>
__device__ __forceinline__ void witem_finish(const WItem& w, const f32x4 (&v)[16], LAS float* scr, int lane) {
#pragma unroll
    for (int i = 0; i < 16; ++i) { LAS float* d = scr + (8 * i + (lane >> 3)) * 33 + (lane & 7) * 4; d[0] = v[i][0]; d[1] = v[i][1]; d[2] = v[i][2]; d[3] = v[i][3]; }
    asm volatile("s_waitcnt lgkmcnt(0)" ::: "memory");
    const int c = lane & 15;
#pragma unroll
    for (int j = 0; j < 8; ++j) { const int n = (lane >> 4) + 4 * j; const LAS float* s = scr + (8 * c) * 33 + n;
        if constexpr (F8) { u32x2 o; o.x = pk_fp8x4(F8_WSCALE * s[0 * 33], F8_WSCALE * s[1 * 33], F8_WSCALE * s[2 * 33], F8_WSCALE * s[3 * 33]); o.y = pk_fp8x4(F8_WSCALE * s[4 * 33], F8_WSCALE * s[5 * 33], F8_WSCALE * s[6 * 33], F8_WSCALE * s[7 * 33]);
            *(u32x2*)((unsigned char*)w.dst + (size_t)n * w.ldd + 8 * c) = o; }
        else { u32x4 o; o.x = cvt_pk_bf16(s[0 * 33], s[1 * 33]); o.y = cvt_pk_bf16(s[2 * 33], s[3 * 33]); o.z = cvt_pk_bf16(s[4 * 33], s[5 * 33]); o.w = cvt_pk_bf16(s[6 * 33], s[7 * 33]);
            *(u32x4*)(w.dst + (size_t)n * w.ldd + 8 * c) = o; } }
    asm volatile("s_waitcnt lgkmcnt(0)" ::: "memory");
}
__device__ __forceinline__ WItem witem_setup(const Params& p, int r) {
    constexpr int I_IN = 8 * 208, I_PA = 4 * 32;
    WItem w;
    if (r < I_IN) { const int kb = r / 208, nb = r % 208; w.src = p.in[10] + (size_t)(128 * kb) * NIN + 32 * nb; w.ld = NIN; w.dst = (bf16_t*)(p.ws + WS_WIN) + (size_t)(32 * nb) * D + 128 * kb; w.ldd = D; return w; } r -= I_IN;
    if (r < I_PA) { const int kb = r / 32, nb = r % 32; w.src = p.in[16] + (size_t)(128 * kb) * D + 32 * nb; w.ld = D; w.dst = (bf16_t*)(p.ws + WS_WPAB) + (size_t)(32 * nb) * 512 + 128 * kb; w.ldd = 512; return w; } r -= I_PA;
    if (r < I_PA) { const int kb = r / 32, nb = r % 32; w.src = p.in[17] + (size_t)(128 * kb) * D + 32 * nb; w.ld = D; w.dst = (bf16_t*)(p.ws + WS_WPAB) + (size_t)D * 512 + (size_t)(32 * nb) * 512 + 128 * kb; w.ldd = 512; return w; } r -= I_PA;
    { const int kb = r / 32, nb = r % 32; w.src = p.in[18] + (size_t)(128 * kb) * D + 32 * nb; w.ld = D; w.dst = (bf16_t*)(p.ws + WS_WOUT) + (size_t)(32 * nb) * D + 128 * kb; w.ldd = D; return w; }
}
__device__ __forceinline__ WItem witem_exp(const Params& p, int r) {
    constexpr int I_GU = NE * 8 * 64;
    WItem w; w.ldd = D;
    if (r < I_GU) { const int e = r / 512, q = r % 512, kb = q / 64, nb = q % 64, n0 = 32 * nb, jj = n0 & 1023, half = n0 >> 10, row0 = (jj >> 7) * 256 + half * 128 + (jj & 127);
        w.src = p.in[21] + (size_t)e * D * 2048 + (size_t)(128 * kb) * 2048 + n0; w.ld = 2048; w.dst = (bf16_t*)(p.ws + WS_WGU + ((size_t)e * 2048 + row0) * D + 128 * kb); return w; } r -= I_GU;
    { const int e = r / 256, q = r % 256, kb = q / 32, nb = q % 32;
        w.src = p.in[23] + (size_t)e * D * D + (size_t)(128 * kb) * D + 32 * nb; w.ld = D; w.dst = (bf16_t*)(p.ws + WS_WDN + ((size_t)e * D + 32 * nb) * D + 128 * kb); return w; }
}
template <bool EXP>
__device__ __forceinline__ void wconvert(const Params& p, LAS unsigned char* lds, int nitems) {
    const int tid = otid(), lane = tid & 63, wave = __builtin_amdgcn_readfirstlane(tid >> 6);
    LAS float* scr = (LAS float*)(lds + wave * 16896);
    const int gw = blockIdx.x * 8 + wave, NGW = gridDim.x * 8;
    f32x4 va[16], vb[16]; WItem wa, wb;
    int it = gw;
    if (it < nitems) { wa = EXP ? witem_exp(p, it) : witem_setup(p, it); witem_load(wa, va, lane); }
#pragma unroll 1
    for (; it < nitems; it += 2 * NGW) {
        const bool hb = it + NGW < nitems;
        if (hb) { wb = EXP ? witem_exp(p, it + NGW) : witem_setup(p, it + NGW); witem_load(wb, vb, lane); }
        witem_finish<EXP>(wa, va, scr, lane);
        if (it + 2 * NGW < nitems) { wa = EXP ? witem_exp(p, it + 2 * NGW) : witem_setup(p, it + 2 * NGW); witem_load(wa, va, lane); }
        if (hb) witem_finish<EXP>(wb, vb, scr, lane);
    }
}
__device__ __forceinline__ void ph_setup(const Params& p, LAS unsigned char* lds) {
    const int tid = otid();
    {
        LAS float* sT = (LAS float*)lds;
        LAS float* red = (LAS float*)(lds + 81920);
        const float* c = p.in[1]; const float* cctx = p.in[3]; const float* w_ada = p.in[4]; const float* b_ada = p.in[5];
        float* mod = (float*)(p.ws + WS_MOD);
        bool did = false;
        for (int item = blockIdx.x; item < 192; item += gridDim.x) {
            if (!did) { for (int idx = tid; idx < 17 * 1024; idx += 512) { const int r = idx >> 10, k = idx & 1023; const float v = r < 16 ? c[r * 1024 + k] : cctx[k]; sT[k * 20 + r] = siluf_(v); } __syncthreads(); did = true; }
            const int col = tid & 31, ks = tid >> 5, j = item * 32 + col;
            float acc[17];
#pragma unroll
            for (int r = 0; r < 17; ++r) acc[r] = 0.f;
            for (int kk = 0; kk < 64; ++kk) { const int k = ks * 64 + kk; const float w = w_ada[(size_t)k * 6144 + j];
#pragma unroll
                for (int r = 0; r < 17; ++r) acc[r] += sT[k * 20 + r] * w; }
#pragma unroll
            for (int r = 0; r < 17; ++r) red[(ks * 17 + r) * 32 + col] = acc[r];
            __syncthreads();
            for (int o = tid; o < 17 * 32; o += 512) { const int r = o >> 5, cc = o & 31; float s = b_ada[item * 32 + cc];
                for (int k2 = 0; k2 < 16; ++k2) s += red[(k2 * 17 + r) * 32 + cc];
                mod[r * 6144 + item * 32 + cc] = s; }
            __syncthreads();
        }
        __syncthreads();
    }
    wconvert<false>(p, lds, 8 * 208 + 2 * 4 * 32 + 8 * 32);
}
__device__ __forceinline__ void ph_wexp(const Params& p, LAS unsigned char* lds) { wconvert<true>(p, lds, NE * 8 * 64 + NE * 8 * 32); }

__device__ __forceinline__ void ph_hl(const Params& p, LAS unsigned char* lds) {
    const int tid = otid(), lane = tid & 63, wave = __builtin_amdgcn_readfirstlane(tid >> 6);
    constexpr int TP = 1025;
    LAS float* tile = (LAS float*)lds;
    const float* w_in = p.in[10];
    const int rt = wave & 1, ksl = wave >> 1;
    float breg[64];
#pragma unroll
    for (int s = 0; s < 64; ++s) breg[s] = w_in[(size_t)(256 * ksl + 4 * s + (lane >> 4)) * NIN + C_MG + (lane & 15)];
    const float* x = p.in[0]; const float* ctx = p.in[2]; const float* wpre = p.in[6]; const float* b_in = p.in[11];
    const float* mod = (const float*)(p.ws + WS_MOD); float* mg = (float*)(p.ws + WS_MG); bf16_t* HL = (bf16_t*)(p.ws + WS_HL);
    f32x4 vg[4][4];
#define HL_LOADG(r0_) do { _Pragma("unroll") for (int tt_ = 0; tt_ < 4; ++tt_) { const int r_ = (r0_) + wave * 4 + tt_; const float* src_ = r_ < NTOK ? x + (size_t)r_ * D : ctx + (size_t)(r_ - NTOK) * D; \
        _Pragma("unroll") for (int j_ = 0; j_ < 4; ++j_) vg[tt_][j_] = __builtin_nontemporal_load((const f32x4*)src_ + lane + 64 * j_); } } while (0)
    if ((int)blockIdx.x < MROWS / 32) HL_LOADG(blockIdx.x * 32);
    for (int grp = blockIdx.x; grp < MROWS / 32; grp += gridDim.x) {
        const int r0 = grp * 32;
        const int b = r0 < NTOK ? (r0 >> 11) : 16;
        const float* sh = mod + b * 6144; const float* sc = sh + 1024;
#pragma unroll
        for (int tt = 0; tt < 4; ++tt) {
            const int rl = wave * 4 + tt, r = r0 + rl;
            f32x4 v[4]; float ss = 0.f;
#pragma unroll
            for (int j = 0; j < 4; ++j) { v[j] = vg[tt][j]; ss += v[j].x * v[j].x + v[j].y * v[j].y + v[j].z * v[j].z + v[j].w * v[j].w; }
            ss = wave_sum(ss); const float rstd = rsqrtf(ss * (1.0f / D) + EPS);
#pragma unroll
            for (int j = 0; j < 4; ++j) { const int ci = 4 * lane + 256 * j;
                const f32x4 wv = *(const f32x4*)(wpre + ci), shv = *(const f32x4*)(sh + ci), scv = *(const f32x4*)(sc + ci);
                LAS float* trow = tile + rl * TP + ci;
                f32x4 h;
#pragma unroll
                for (int i = 0; i < 4; ++i) { h[i] = v[j][i] * rstd * wv[i] * (1.0f + scv[i]) + shv[i]; trow[i] = h[i]; }
                u32x2 o; o.x = cvt_pk_bf16(h[0], h[1]); o.y = cvt_pk_bf16(h[2], h[3]);
                *(u32x2*)(HL + (size_t)r * D + ci) = o; }
        }
        __syncthreads();
        if (grp + (int)gridDim.x < MROWS / 32) HL_LOADG((grp + (int)gridDim.x) * 32);
        f32x4 acc = (f32x4){0.f, 0.f, 0.f, 0.f};
        { const LAS float* ap = tile + (16 * rt + (lane & 15)) * TP + 256 * ksl + (lane >> 4);
#pragma unroll
            for (int s = 0; s < 64; ++s) acc = __builtin_amdgcn_mfma_f32_16x16x4f32(ap[4 * s], breg[s], acc, 0, 0, 0); }
        __syncthreads();
#pragma unroll
        for (int r = 0; r < 4; ++r) tile[(ksl * 32 + 16 * rt + 4 * (lane >> 4) + r) * 16 + (lane & 15)] = acc[r];
        __syncthreads();
        { const int row = tid >> 4, col = tid & 15; mg[(size_t)(r0 + row) * 16 + col] = b_in[C_MG + col] + (tile[row * 16 + col] + tile[(32 + row) * 16 + col]) + (tile[(64 + row) * 16 + col] + tile[(96 + row) * 16 + col]); }
        __syncthreads();
    }
}

__device__ __forceinline__ float logsigf_(float x) { return fminf(x, 0.f) - __logf(1.0f + __expf(-fabsf(x))); }
__device__ __forceinline__ bf16_t tobf(float f) { return (bf16_t)(cvt_pk_bf16(f, 0.f) & 0xffffu); }
__device__ __forceinline__ float ldsbf(const LAS unsigned char* p) { return __uint_as_float(((unsigned)*(const LAS bf16_t*)p) << 16); }
constexpr int PR_HALO = 256, PR_T = 49408, PR_W = 131328, PR_SEG = 131840, PR_SEGSZ = 8192;
static_assert(PR_SEG + PR_SEGSZ <= LDS_BYTES - 16, "prep LDS map");
__device__ __forceinline__ void pr_dma_tile(LAS unsigned char* lds, int ldsoff, const char* gsrc, size_t pitchB, int w, int lane) {
#pragma unroll
    for (int i = 0; i < 2; ++i) { const int r0 = 8 * w + 4 * i;
        __builtin_amdgcn_global_load_lds((const unsigned*)(gsrc + (size_t)(r0 + (lane >> 4)) * pitchB + (lane & 15) * 16), (LAS unsigned*)(lds + ldsoff + r0 * 256), 16, 0, 0); }
}
__device__ __forceinline__ void pr_flush_nat(const LAS unsigned char* lds, int ldsoff, char* gdst, size_t pitchB, int tid) {
#pragma unroll
    for (int ps = 0; ps < 2; ++ps) { const int row = (tid >> 4) + 32 * ps, u = tid & 15; *(u32x4*)(gdst + (size_t)row * pitchB + u * 16) = *(const LAS u32x4*)(lds + ldsoff + row * 256 + u * 16); }
}
__device__ __forceinline__ void pr_flush_tr(const LAS unsigned char* lds, int ldsoff, char* gdst, int tid) {
#pragma unroll
    for (int ps = 0; ps < 2; ++ps) { const int idx = tid + 512 * ps, c = idx >> 3, u = idx & 7; *(u32x4*)(gdst + (size_t)idx * 16) = *(const LAS u32x4*)(lds + ldsoff + c * 128 + ((u ^ (c & 7)) << 4)); }
}
__device__ __forceinline__ f32x2 ldsbf2(const LAS unsigned char* p) { const unsigned w = *(const LAS unsigned*)p; return (f32x2){bf_lo(w), bf_hi(w)}; }
__device__ __forceinline__ f32x2 exp2v(f32x2 x) { return (f32x2){__expf(x.x), __expf(x.y)}; }
__device__ __forceinline__ f32x2 log1mv(f32x2 k) { return (f32x2){__logf(1.0f - k.x), __logf(1.0f - k.y)}; }
__device__ __forceinline__ void pr_tstore8(LAS unsigned char* lds, int ldsoff, int cp, int seg, const f32x2 (&f)[8]) {
    u32x4 a, b;
    a.x = cvt_pk_bf16(f[0].x, f[1].x); a.y = cvt_pk_bf16(f[2].x, f[3].x); a.z = cvt_pk_bf16(f[4].x, f[5].x); a.w = cvt_pk_bf16(f[6].x, f[7].x);
    b.x = cvt_pk_bf16(f[0].y, f[1].y); b.y = cvt_pk_bf16(f[2].y, f[3].y); b.z = cvt_pk_bf16(f[4].y, f[5].y); b.w = cvt_pk_bf16(f[6].y, f[7].y);
    const int c0 = 2 * cp, c1 = 2 * cp + 1;
    *(LAS u32x4*)(lds + ldsoff + c0 * 128 + ((seg ^ (c0 & 7)) << 4)) = a;
    *(LAS u32x4*)(lds + ldsoff + c1 * 128 + ((seg ^ (c1 & 7)) << 4)) = b;
}
__device__ __forceinline__ void pr_conv8p(const LAS unsigned char* halo, const f32x2 (&cwv)[9], bool lat, int cc, int s0, int cp, f32x2 (&o)[8]) {
#pragma unroll
    for (int j = 0; j < 8; ++j) o[j] = (f32x2){0.f, 0.f};
    if (lat) {
        const int gi = cc - 4;
#pragma unroll
        for (int di = 0; di < 3; ++di) {
            const int ii = gi + di - 1; const bool rok = ii >= 0 && ii < 32;
            f32x2 x[10];
#pragma unroll
            for (int jj = 0; jj < 10; ++jj) { const int gj = s0 + jj - 1; const f32x2 v = ldsbf2(halo + di * 16384 + gj * 256 + cp * 4); x[jj] = (rok && gj >= 0 && gj < 64) ? v : (f32x2){0.f, 0.f}; }
#pragma unroll
            for (int dj = 0; dj < 3; ++dj) { const f32x2 w = cwv[di * 3 + dj];
#pragma unroll
                for (int j = 0; j < 8; ++j) o[j] += w * x[j + dj]; }
        }
    } else {
        f32x2 x[10];
#pragma unroll
        for (int jj = 0; jj < 10; ++jj) { const int fl = 64 + s0 + jj - 1, tt = cc * 64 + s0 + jj - 1; const f32x2 v = ldsbf2(halo + fl * 256 + cp * 4); x[jj] = (tt >= 0 && tt < TC) ? v : (f32x2){0.f, 0.f}; }
#pragma unroll
        for (int dj = 0; dj < 3; ++dj) { const f32x2 w = cwv[3 + dj];
#pragma unroll
            for (int j = 0; j < 8; ++j) o[j] += w * x[j + dj]; }
    }
}
#define PR_BAR() do { asm volatile("s_waitcnt lgkmcnt(0)" ::: "memory"); __builtin_amdgcn_s_barrier(); asm volatile("" ::: "memory"); } while (0)
__device__ __forceinline__ void ph_prep(const Params& p, LAS unsigned char* lds) {
    const int tid = otid(), lane = tid & 63, wave = __builtin_amdgcn_readfirstlane(tid >> 6);
    const int cp = tid & 63, seg = tid >> 6, s0 = 8 * seg;
    LAS float* wS = (LAS float*)(lds + PR_W);
    LAS float* segS = (LAS float*)(lds + PR_SEG);
    const char* PD = (const char*)(p.ws + WS_PD); char* QK = (char*)(p.ws + WS_QK);
    const float* mg = (const float*)(p.ws + WS_MG); const float* cw = p.in[12];
    float* GW = (float*)(p.ws + WS_GW); float* G1 = (float*)(p.ws + WS_G1); bf16_t* WB = (bf16_t*)(p.ws + WS_WB);
    float* DEC = (float*)(p.ws + WS_DEC); float* EAL = (float*)(p.ws + WS_EAL);
    constexpr int T0 = PR_T, T1 = PR_T + 16384, T2 = PR_T + 32768, T3 = PR_T + 49152, T4 = PR_T + 65536, H0 = PR_HALO, H1 = PR_HALO + 16384, H2 = PR_HALO + 32768;
    constexpr size_t PDP = (size_t)PD_W * 2;
    for (int unit = blockIdx.x; unit < NB * 36 * 4; unit += gridDim.x) {
        const int h = unit & 3, cc = (unit >> 2) % 36, b = unit / 144;
        const bool lat = cc >= 4; const int u0 = cc * 64; const int row0 = lat ? b * T + (cc - 4) * 64 : NTOK + b * TC + cc * 64;
        const int bh = b * 4 + h;
        const size_t trb = ((size_t)bh * 36 + cc) * 16384;
        {
            const int colk = PD_MK + h * 128;
#pragma unroll
            for (int di = 0; di < 3; ++di) { const int rr = lat ? (cc - 4) + di - 1 : cc + di - 1; const bool ok = lat ? (rr >= 0 && rr < 32) : (rr >= 0 && rr < 4);
                if (ok) pr_dma_tile(lds, PR_HALO + di * 16384, PD + (size_t)(lat ? b * T + rr * 64 : NTOK + b * TC + rr * 64) * PDP + colk * 2, PDP, wave, lane); }
            pr_dma_tile(lds, T0, PD + (size_t)row0 * PDP + (PD_MV + h * 128) * 2, PDP, wave, lane);
        }
        f32x2 wk[9], wq[9];
#pragma unroll
        for (int t9 = 0; t9 < 9; ++t9) { wk[t9] = *(const f32x2*)(cw + t9 * 1024 + PD_MK + h * 128 + 2 * cp); wq[t9] = *(const f32x2*)(cw + t9 * 1024 + PD_MQ + h * 128 + 2 * cp); }
        if (wave < 2) {
            const int dir = wave; const int s = dir ? 63 - lane : lane; const float* g = mg + (size_t)(row0 + s) * 16;
            const float ipre = g[dir * 4 + h], fpre = g[(2 + dir) * 4 + h]; float bs = logsigf_(fpre);
#pragma unroll
            for (int o = 1; o < 64; o <<= 1) { const float tt = __shfl_up(bs, o); if (lane >= o) bs += tt; }
            const float bL = __shfl(bs, 63); const float w = __expf(bL - bs + ipre), g1 = __expf(bs - bL);
            const size_t gi = (size_t)(bh * 2 + dir) * 2304 + u0; wS[dir * 64 + s] = w; GW[gi + s] = w; G1[gi + s] = g1;
            WB[gi + s] = tobf(w);
            if (lane == 63) DEC[(bh * 2 + dir) * 36 + cc] = __expf(bL);
        }
        asm volatile("s_waitcnt vmcnt(0)" ::: "memory"); PR_BAR();
        {
            f32x2 o[8];
            pr_conv8p(lds + PR_HALO, wk, lat, cc, s0, cp, o);
#pragma unroll
            for (int j = 0; j < 8; ++j) { o[j].x = siluf_(o[j].x); o[j].y = siluf_(o[j].y); }
            pr_tstore8(lds, T2, cp, seg, o);
            asm volatile("" ::: "memory");
            f32x2 vf[8];
#pragma unroll
            for (int j = 0; j < 8; ++j) { o[j] = ldsbf2(lds + T0 + (s0 + j) * 256 + cp * 4); vf[j] = o[j] * wS[s0 + j]; }
            pr_tstore8(lds, T3, cp, seg, vf);
            asm volatile("" ::: "memory");
#pragma unroll
            for (int j = 0; j < 8; ++j) vf[j] = o[j] * wS[64 + s0 + j];
            pr_tstore8(lds, T4, cp, seg, vf);
        }
        PR_BAR();
        if (lat) {
#pragma unroll
            for (int di = 0; di < 3; ++di) { const int rr = (cc - 4) + di - 1; if (rr >= 0 && rr < 32) pr_dma_tile(lds, PR_HALO + di * 16384, PD + (size_t)(b * T + rr * 64) * PDP + (PD_MQ + h * 128) * 2, PDP, wave, lane); }
        }
        pr_dma_tile(lds, T0, PD + (size_t)row0 * PDP + (PD_HF + h * 128) * 2, PDP, wave, lane);
        pr_flush_tr(lds, T2, (char*)(p.ws + WS_KT) + trb, tid); pr_flush_tr(lds, T3, (char*)(p.ws + WS_VTF) + trb, tid); pr_flush_tr(lds, T4, (char*)(p.ws + WS_VTB) + trb, tid);
        PR_BAR();
        pr_dma_tile(lds, T2, PD + (size_t)row0 * PDP + (PD_HF + 512 + h * 128) * 2, PDP, wave, lane);
        if (lat) pr_dma_tile(lds, T3, PD + (size_t)row0 * PDP + (PD_HQ + h * 128) * 2, PDP, wave, lane);
        pr_dma_tile(lds, T4, PD + (size_t)row0 * PDP + (PD_HI + h * 128) * 2, PDP, wave, lane);
        if (lat) {
            asm volatile("s_waitcnt vmcnt(6)" ::: "memory"); PR_BAR();
            f32x2 o[8];
            pr_conv8p(lds + PR_HALO, wq, true, cc, s0, cp, o);
#pragma unroll
            for (int j = 0; j < 8; ++j) *(LAS unsigned*)(lds + T1 + (s0 + j) * 256 + cp * 4) = cvt_pk_bf16(siluf_(o[j].x) * 0.08838834764831845f, siluf_(o[j].y) * 0.08838834764831845f);
            PR_BAR();
            pr_flush_nat(lds, T1, QK + (size_t)row0 * (D * 2) + (h * 128) * 2, (size_t)D * 2, tid);
        }
        asm volatile("s_waitcnt vmcnt(0)" ::: "memory"); PR_BAR();
        {
            const int ob = s0 * 256 + cp * 4;
            f32x2 locf = (f32x2){0.f, 0.f}, locb = locf;
            { f32x2 iv[8];
#pragma unroll
                for (int j = 0; j < 8; ++j) { iv[j] = ldsbf2(lds + T4 + ob + j * 256); locf += log1mv(ldsbf2(lds + T0 + ob + j * 256)); locb += log1mv(ldsbf2(lds + T2 + ob + j * 256)); }
                pr_tstore8(lds, H0, cp, seg, iv); }
            *(LAS f32x2*)(segS + seg * 128 + 2 * cp) = locf; *(LAS f32x2*)(segS + (8 + seg) * 128 + 2 * cp) = locb;
            PR_BAR();
            f32x2 pf = (f32x2){0.f, 0.f}, tf = pf, pb = pf, tbk = pf;
#pragma unroll
            for (int sg = 0; sg < 8; ++sg) { const f32x2 a = *(const LAS f32x2*)(segS + sg * 128 + 2 * cp), bq = *(const LAS f32x2*)(segS + (8 + sg) * 128 + 2 * cp); tf += a; tbk += bq; if (sg < seg) { pf += a; pb += bq; } }
            f32x2 ke[8];
            {
                f32x2 run = pf;
#pragma unroll
                for (int j = 0; j < 8; ++j) { const f32x2 kk = ldsbf2(lds + T0 + ob + j * 256), qv = ldsbf2(lds + T3 + ob + j * 256); run += log1mv(kk);
                    f32x2 x = tf - run; x.x = fmaxf(x.x, -80.f); x.y = fmaxf(x.y, -80.f);
                    ke[j] = kk * exp2v(x); const f32x2 qp = qv * exp2v(-x);
                    *(LAS unsigned*)(lds + T1 + ob + j * 256) = lat ? cvt_pk_bf16(qp.x, qp.y) : 0u; }
                pr_tstore8(lds, H1, cp, seg, ke);
            }
            asm volatile("" ::: "memory");
            {
                f32x2 E = pb;
#pragma unroll
                for (int j = 0; j < 8; ++j) { const f32x2 kk = ldsbf2(lds + T2 + ob + j * 256), qv = ldsbf2(lds + T3 + ob + j * 256);
                    f32x2 x = E; x.x = fmaxf(x.x, -80.f); x.y = fmaxf(x.y, -80.f); E += log1mv(kk);
                    ke[j] = kk * exp2v(x); const f32x2 qp = qv * exp2v(-x);
                    *(LAS unsigned*)(lds + T3 + ob + j * 256) = lat ? cvt_pk_bf16(qp.x, qp.y) : 0u; }
                pr_tstore8(lds, H2, cp, seg, ke);
            }
            if (seg == 0) { *(f32x2*)(EAL + ((size_t)(bh * 2 + 0) * 36 + cc) * 128 + 2 * cp) = exp2v(tf); *(f32x2*)(EAL + ((size_t)(bh * 2 + 1) * 36 + cc) * 128 + 2 * cp) = exp2v(tbk); }
        }
        PR_BAR();
        pr_flush_tr(lds, H0, (char*)(p.ws + WS_IT) + trb, tid); pr_flush_tr(lds, H1, (char*)(p.ws + WS_KEFT) + trb, tid); pr_flush_tr(lds, H2, (char*)(p.ws + WS_KEBT) + trb, tid);
        if (lat) { const size_t no = (size_t)row0 * 1024 + (h * 128) * 2;
            pr_flush_nat(lds, T1, (char*)(p.ws + WS_QPFN) + no, 1024, tid); pr_flush_nat(lds, T3, (char*)(p.ws + WS_QPBN) + no, 1024, tid); }
        PR_BAR();
    }
}

#undef PR_BAR
#define MFMA16(a, b, c) __builtin_amdgcn_mfma_f32_16x16x32_bf16((a), (b), (c), 0, 0, 0)
constexpr int SC_ST = 0, SC_BUF = 32768, SC_BUFSZ = 32768, SC_KT = 0, SC_VT = 16384;
constexpr int SC_VEC = SC_BUF + 3 * SC_BUFSZ, SC_VECSZ = 1536, SC_GW = 0, SC_G1 = 256, SC_WB = 512, SC_EAL = 1024, SC_NS = SC_VEC + 3 * SC_VECSZ, SC_DUMMY = SC_NS + 512;
static_assert(SC_DUMMY + 256 <= LDS_BYTES - 16, "scan LDS map");
typedef unsigned short u16x4 __attribute__((ext_vector_type(4)));
template <bool MLSTM>
__device__ __forceinline__ void scan2_item(const Params& p, LAS unsigned char* lds, int b, int h, int dir) {
    const int tid = otid(), lane = tid & 63, w = __builtin_amdgcn_readfirstlane(tid >> 6), j15 = lane & 15, kq = lane >> 4;
    const int dh = w >> 2, vq = w & 3, rb = w & 3, vh = w >> 2;
    const int bh = b * 4 + h, bhd = bh * 2 + dir;
    const int npitch = MLSTM ? D : 512;
    const bf16_t* QNarr = MLSTM ? (const bf16_t*)(p.ws + WS_QK) + h * 128 : (const bf16_t*)(p.ws + (dir ? WS_QPBN : WS_QPFN)) + h * 128;
    const bf16_t* KTarr = (const bf16_t*)(p.ws + (MLSTM ? WS_KT : (dir ? WS_KEBT : WS_KEFT))) + (size_t)bh * 36 * 8192;
    const bf16_t* VTarr = (const bf16_t*)(p.ws + (MLSTM ? (dir ? WS_VTB : WS_VTF) : WS_IT)) + (size_t)bh * 36 * 8192;
    const float* GWarr = (const float*)(p.ws + WS_GW) + (size_t)bhd * 2304; const float* G1arr = (const float*)(p.ws + WS_G1) + (size_t)bhd * 2304;
    const bf16_t* WBarr = (const bf16_t*)(p.ws + WS_WB) + (size_t)bhd * 2304; const float* EALarr = (const float*)(p.ws + WS_EAL) + (size_t)bhd * 36 * 128;
    const float* DEC = (const float*)(p.ws + WS_DEC) + bhd * 36;
    bf16_t* HSo = (bf16_t*)(p.ws + WS_HS) + (size_t)((MLSTM ? 0 : 2) + dir) * NTOK * 512 + h * 128;
    unsigned doff[4];
#pragma unroll
    for (int i = 0; i < 4; ++i) { const int idx = (w * 4 + i) & 15; doff[i] = (unsigned)(((16 * (idx >> 1) + j15) * 64 + 32 * (idx & 1) + 8 * kq) * 2); }
    const unsigned trL = (unsigned)((kq >> 1) * 2048 + (kq & 1) * 128 + ((lane & 15) >> 2) * 16 + ((lane & 3) >> 1) * 256 + (lane & 1) * 8);
    const unsigned vtL = (unsigned)(j15 * 16 + (kq >> 1) * 256 + (kq & 1) * 8);
#define SC_CC(st) (dir == 0 ? (st) : ((st) < 4 ? 3 - (st) : 39 - (st)))
#define SC_ROW0(cc) ((cc) >= 4 ? b * T + ((cc) - 4) * 64 : NTOK + b * TC + (cc) * 64)
#define SC_DMA(st, bufi) do { const int cc_ = SC_CC(st); const unsigned bo_ = SC_BUF + (bufi) * SC_BUFSZ; \
        const char* kt_ = (const char*)(KTarr + (size_t)cc_ * 8192); const char* vt_ = (const char*)(VTarr + (size_t)cc_ * 8192); \
        _Pragma("unroll") for (int i = 0; i < 4; ++i) { const int f = w * 4 + i; const char* g_ = (f < 16 ? kt_ : vt_) + doff[i]; \
            __builtin_amdgcn_global_load_lds((const unsigned*)g_, (LAS unsigned*)(lds + bo_ + f * 1024), 16, 0, 0); } \
        const unsigned vo_ = SC_VEC + (bufi) * SC_VECSZ; const unsigned* vs_ = (const unsigned*)DEC; unsigned vd_ = SC_DUMMY; int lm_ = 0; \
        if (MLSTM) { if (w == 0) { vs_ = (const unsigned*)(GWarr + cc_ * 64); vd_ = vo_ + SC_GW; lm_ = 1; } if (w == 1) { vs_ = (const unsigned*)(G1arr + cc_ * 64); vd_ = vo_ + SC_G1; lm_ = 1; } \
            if (w == 2) { vs_ = (const unsigned*)(WBarr + cc_ * 64); vd_ = vo_ + SC_WB; lm_ = 1; } if (w == 3) { vs_ = (const unsigned*)(DEC + cc_); vd_ = vo_ + SC_EAL; } } \
        else { if (w == 3 || w == 4) { vs_ = (const unsigned*)(EALarr + cc_ * 128 + (w - 3) * 64); vd_ = vo_ + SC_EAL + (w - 3) * 256; lm_ = 1; } } \
        __builtin_amdgcn_global_load_lds(vs_ + lm_ * lane, (LAS unsigned*)(lds + vd_), 4, 0, 0); } while (0)
#define SC_LOADQ(Q, st) do { const int cc_ = SC_CC(st); const bf16_t* qp_ = QNarr + (size_t)(SC_ROW0(cc_) + 16 * rb + j15) * npitch + 8 * kq; \
        asm volatile("global_load_dwordx4 %0, %4, off\n\tglobal_load_dwordx4 %1, %4, off offset:64\n\tglobal_load_dwordx4 %2, %4, off offset:128\n\tglobal_load_dwordx4 %3, %4, off offset:192" \
            : "=&v"(Q[0]), "=&v"(Q[1]), "=&v"(Q[2]), "=&v"(Q[3]) : "v"(qp_) : "memory"); } while (0)
    f32x4 acc[4][2], accn = (f32x4){0.f, 0.f, 0.f, 0.f};
#pragma unroll
    for (int dt = 0; dt < 4; ++dt)
#pragma unroll
        for (int vt = 0; vt < 2; ++vt) acc[dt][vt] = (f32x4){0.f, 0.f, 0.f, 0.f};
    bf16x8 Qa[4], Qb[4];
#pragma unroll
    for (int ks = 0; ks < 4; ++ks) { Qa[ks] = (bf16x8){0, 0, 0, 0, 0, 0, 0, 0}; Qb[ks] = Qa[ks]; }
    __syncthreads();
    if (SC_CC(0) >= 4) SC_LOADQ(Qa, 0);
    SC_DMA(0, 0); SC_DMA(1, 1);
#define SC_WAITFOR(s_) do { if ((s_) == 0) asm volatile("s_waitcnt vmcnt(5)" ::: "memory"); \
        else if ((s_) + 1 < 36) { if (SC_CC((s_) - 1) >= 4) asm volatile("s_waitcnt vmcnt(9)" ::: "memory"); else asm volatile("s_waitcnt vmcnt(5)" ::: "memory"); } \
        else asm volatile("s_waitcnt vmcnt(0)" ::: "memory"); } while (0)
    SC_WAITFOR(0);
#define SC_STEP(Q, QN, st) do { const int cc = SC_CC(st); const bool lat = cc >= 4; const int bi = (st) % 3; \
        const LAS unsigned char* B_ = lds + SC_BUF + bi * SC_BUFSZ; const LAS unsigned char* V_ = lds + SC_VEC + bi * SC_VECSZ; \
        __builtin_amdgcn_s_barrier(); asm volatile("" ::: "memory"); \
        _Pragma("unroll") for (int ks = 0; ks < 4; ++ks) asm volatile("" : "+v"(Q[ks])); \
        if ((st) + 1 < 36 && SC_CC((st) + 1) >= 4) SC_LOADQ(QN, (st) + 1); \
        if ((st) + 2 < 36) { SC_DMA((st) + 2, ((st) + 2) % 3); } \
          \
        if (MLSTM) { const float dec = *(const LAS float*)(V_ + SC_EAL); _Pragma("unroll") for (int dt = 0; dt < 4; ++dt) _Pragma("unroll") for (int vt = 0; vt < 2; ++vt) acc[dt][vt] *= dec; accn *= dec; } \
        else { _Pragma("unroll") for (int dt = 0; dt < 4; ++dt) { const f32x4 e = *(const LAS f32x4*)(V_ + SC_EAL + (64 * dh + 16 * dt + 4 * kq) * 4); _Pragma("unroll") for (int vt = 0; vt < 2; ++vt) acc[dt][vt] *= e; } } \
        if (lat) { _Pragma("unroll") for (int dt = 0; dt < 4; ++dt) _Pragma("unroll") for (int vt = 0; vt < 2; ++vt) { u32x2 v_; v_.x = cvt_pk_bf16(acc[dt][vt][0], acc[dt][vt][1]); v_.y = cvt_pk_bf16(acc[dt][vt][2], acc[dt][vt][3]); \
                *(LAS u32x2*)(lds + SC_ST + (32 * vq + 16 * vt + j15) * 256 + (((8 * dh + 2 * dt + (kq >> 1)) ^ j15) << 4) + 8 * (kq & 1)) = v_; } \
            if (MLSTM && j15 == 0) *(LAS f32x4*)(lds + SC_NS + (16 * (4 * dh + vq) + 4 * kq) * 4) = accn; } \
        asm volatile("s_waitcnt lgkmcnt(0)" ::: "memory"); __builtin_amdgcn_s_barrier(); asm volatile("" ::: "memory"); \
        if (lat) { const int t = 16 * rb + j15; f32x4 Gt[4]; const unsigned tra_ = (unsigned)(size_t)(B_ + SC_KT) + trL; \
            _Pragma("unroll") for (int s4 = 0; s4 < 4; ++s4) { Gt[s4] = (f32x4){0.f, 0.f, 0.f, 0.f}; u16x4 k0_[4], k1_[4]; \
                _Pragma("unroll") for (int ks = 0; ks < 4; ++ks) { const unsigned a_ = tra_ + ks * 4096 + (s4 >> 1) * 1024 + (s4 & 1) * 512; \
                    asm volatile("ds_read_b64_tr_b16 %0, %2\n\tds_read_b64_tr_b16 %1, %2 offset:64" : "=&v"(k0_[ks]), "=&v"(k1_[ks]) : "v"(a_) : "memory"); } \
                asm volatile("s_waitcnt lgkmcnt(0)" ::: "memory"); __builtin_amdgcn_sched_barrier(0); \
                _Pragma("unroll") for (int ks = 0; ks < 4; ++ks) { const u32x2 lo_ = __builtin_bit_cast(u32x2, k0_[ks]), hi_ = __builtin_bit_cast(u32x2, k1_[ks]); u32x4 kk_; kk_.x = lo_.x; kk_.y = lo_.y; kk_.z = hi_.x; kk_.w = hi_.y; \
                    Gt[s4] = MFMA16(__builtin_bit_cast(bf16x8, kk_), Q[ks], Gt[s4]); } } \
            float dsum = 0.f; unsigned pk_[8]; \
            _Pragma("unroll") for (int s4 = 0; s4 < 4; ++s4) { f32x4 wv = (f32x4){0.f, 0.f, 0.f, 0.f}; if (MLSTM) wv = *(const LAS f32x4*)(V_ + SC_GW + (16 * s4 + 4 * kq) * 4); float gm[4]; \
                _Pragma("unroll") for (int r = 0; r < 4; ++r) { const int s = 16 * s4 + 4 * kq + r; const bool keep = dir == 0 ? (s <= t) : (s >= t); gm[r] = keep ? Gt[s4][r] : 0.f; dsum += gm[r] * wv[r]; } \
                pk_[2 * s4] = cvt_pk_bf16(gm[0], gm[1]); pk_[2 * s4 + 1] = cvt_pk_bf16(gm[2], gm[3]); } \
            bf16x8 Pf[2]; { u32x4 t0; t0.x = pk_[0]; t0.y = pk_[1]; t0.z = pk_[2]; t0.w = pk_[3]; Pf[0] = __builtin_bit_cast(bf16x8, t0); u32x4 t1; t1.x = pk_[4]; t1.y = pk_[5]; t1.z = pk_[6]; t1.w = pk_[7]; Pf[1] = __builtin_bit_cast(bf16x8, t1); } \
            f32x4 Ot[4]; \
            _Pragma("unroll") for (int vt = 0; vt < 4; ++vt) { Ot[vt] = (f32x4){0.f, 0.f, 0.f, 0.f}; const int v8 = 4 * vh + vt; \
                _Pragma("unroll") for (int ks = 0; ks < 4; ++ks) Ot[vt] = MFMA16(*(const LAS bf16x8*)(lds + SC_ST + (16 * v8 + j15) * 256 + (((4 * ks + kq) ^ j15) << 4)), Q[ks], Ot[vt]); \
                _Pragma("unroll") for (int ks = 0; ks < 2; ++ks) { const LAS unsigned char* vp_ = B_ + SC_VT + vtL + v8 * 2048 + ks * 1024; const u32x2 lo_ = *(const LAS u32x2*)vp_, hi_ = *(const LAS u32x2*)(vp_ + 512); \
                    u32x4 vv_; vv_.x = lo_.x; vv_.y = lo_.y; vv_.z = hi_.x; vv_.w = hi_.y; Ot[vt] = MFMA16(__builtin_bit_cast(bf16x8, vv_), Pf[ks], Ot[vt]); } \
                asm volatile("" ::: "memory"); } \
            float sc = 1.0f; \
            if (MLSTM) { float nint = 0.f; \
                _Pragma("unroll") for (int ks = 0; ks < 4; ++ks) { const f32x4 n0 = *(const LAS f32x4*)(lds + SC_NS + (32 * ks + 8 * kq) * 4), n1 = *(const LAS f32x4*)(lds + SC_NS + (32 * ks + 8 * kq + 4) * 4); float q[8]; unpack8(__builtin_bit_cast(u32x4, Q[ks]), q); \
                    nint += q[0] * n0[0] + q[1] * n0[1] + q[2] * n0[2] + q[3] * n0[3] + q[4] * n1[0] + q[5] * n1[1] + q[6] * n1[2] + q[7] * n1[3]; } \
                float tot = dsum + nint; tot += __shfl_xor(tot, 16); tot += __shfl_xor(tot, 32); \
                const float g1 = *(const LAS float*)(V_ + SC_G1 + t * 4); sc = g1 / fmaxf(fabsf(g1 * tot), 1.0f); } \
            bf16_t* op_ = HSo + (size_t)(SC_ROW0(cc) + t) * 512 + 64 * vh + 4 * kq; \
            _Pragma("unroll") for (int vt = 0; vt < 4; ++vt) { u32x2 o_; o_.x = cvt_pk_bf16(Ot[vt][0] * sc, Ot[vt][1] * sc); o_.y = cvt_pk_bf16(Ot[vt][2] * sc, Ot[vt][3] * sc); *(u32x2*)(op_ + 16 * vt) = o_; } } \
          \
        _Pragma("unroll") for (int ks = 0; ks < 2; ++ks) { bf16x8 vf_[2]; _Pragma("unroll") for (int vt = 0; vt < 2; ++vt) vf_[vt] = *(const LAS bf16x8*)(B_ + SC_VT + ((2 * vq + vt) * 2 + ks) * 1024 + lane * 16); \
            _Pragma("unroll") for (int dt = 0; dt < 4; ++dt) { const bf16x8 kf_ = *(const LAS bf16x8*)(B_ + SC_KT + ((4 * dh + dt) * 2 + ks) * 1024 + lane * 16); \
                _Pragma("unroll") for (int vt = 0; vt < 2; ++vt) acc[dt][vt] = MFMA16(kf_, vf_[vt], acc[dt][vt]); } \
            if (MLSTM) { const bf16x8 kn_ = *(const LAS bf16x8*)(B_ + SC_KT + ((4 * dh + vq) * 2 + ks) * 1024 + lane * 16); bf16x8 wf_ = *(const LAS bf16x8*)(V_ + SC_WB + (32 * ks + 8 * kq) * 2); \
                if (j15 != 0) wf_ = (bf16x8){0, 0, 0, 0, 0, 0, 0, 0}; accn = MFMA16(kn_, wf_, accn); } } \
        SC_WAITFOR((st) + 1); \
    } while (0)
#pragma unroll 1
    for (int step = 0; step < 36; step += 2) { SC_STEP(Qa, Qb, step); SC_STEP(Qb, Qa, step + 1); }
    asm volatile("s_waitcnt vmcnt(0) lgkmcnt(0)" ::: "memory");
#undef SC_STEP
#undef SC_WAITFOR
#undef SC_LOADQ
#undef SC_DMA
#undef SC_ROW0
#undef SC_CC
}
__device__ __forceinline__ void ph_scan2(const Params& p, LAS unsigned char* lds) {
    for (int item = blockIdx.x; item < 256; item += gridDim.x) {
        const int kind = item >> 7, r = item & 127, b = r >> 3, h = (r >> 1) & 3, dir = r & 1;
        if (kind == 0) scan2_item<true>(p, lds, b, h, dir); else scan2_item<false>(p, lds, b, h, dir);
    }
    __syncthreads();
}

__device__ __forceinline__ void ph_merge(const Params& p) {
    const int tid = otid(), lane = tid & 63, wave = __builtin_amdgcn_readfirstlane(tid >> 6);
    const bf16_t* PL = (const bf16_t*)(p.ws + WS_PL); const bf16_t* HS = (const bf16_t*)(p.ws + WS_HS); bf16_t* AB = (bf16_t*)(p.ws + WS_AB);
    const float* m_norm = p.in[14]; const float* h_norm = p.in[15];
    const int gw = blockIdx.x * 8 + wave, NGW = gridDim.x * 8, c0 = lane * 8;
    u32x4 n0[2], n1[2], ng[2];
#define MG_LOAD(tok_) do { _Pragma("unroll") for (int kind_ = 0; kind_ < 2; ++kind_) { n0[kind_] = __builtin_nontemporal_load((const u32x4*)(HS + ((size_t)(2 * kind_) * NTOK + (tok_)) * 512 + c0)); \
        n1[kind_] = __builtin_nontemporal_load((const u32x4*)(HS + ((size_t)(2 * kind_ + 1) * NTOK + (tok_)) * 512 + c0)); ng[kind_] = *(const u32x4*)(PL + (size_t)(tok_) * PL_W + (kind_ ? PL_HG : PL_MO) + c0); } } while (0)
    if (gw < NTOK) MG_LOAD(gw);
    for (int tok = gw; tok < NTOK; tok += NGW) {
        u32x4 c0r[2], c1r[2], cgr[2];
#pragma unroll
        for (int kind = 0; kind < 2; ++kind) { c0r[kind] = n0[kind]; c1r[kind] = n1[kind]; cgr[kind] = ng[kind]; }
        if (tok + NGW < NTOK) MG_LOAD(tok + NGW);
#pragma unroll
        for (int kind = 0; kind < 2; ++kind) {
            const u32x4 r0 = c0r[kind], r1 = c1r[kind];
            const u32x4 rg = cgr[kind];
            const float* nw = (kind ? h_norm : m_norm) + c0; const f32x4 w0 = *(const f32x4*)nw, w1 = *(const f32x4*)(nw + 4);
            float a[8], b[8], g[8]; unpack8(r0, a); unpack8(r1, b); unpack8(rg, g);
            float ss = 0.f;
#pragma unroll
            for (int i = 0; i < 8; ++i) { a[i] += b[i]; ss += a[i] * a[i]; }
            ss += __shfl_xor(ss, 1); ss += __shfl_xor(ss, 2); ss += __shfl_xor(ss, 4); ss += __shfl_xor(ss, 8);
            const float rstd = rsqrtf(ss * (1.0f / 128.0f) + EPS);
#pragma unroll
            for (int i = 0; i < 8; ++i) a[i] = a[i] * rstd * (i < 4 ? w0[i] : w1[i - 4]) * g[i];
            *(u32x4*)(AB + ((size_t)kind * NTOK + tok) * 512 + c0) = pack8(a);
        }
    }
}

typedef float f32x16 __attribute__((ext_vector_type(16)));
__device__ __forceinline__ void ph_post(const Params& p, LAS unsigned char* lds) {
    const int tid = otid(), lane = tid & 63, wave = __builtin_amdgcn_readfirstlane(tid >> 6);
    constexpr int TP = 1025;
    LAS float* tile = (LAS float*)lds;
    LAS float* vec = (LAS float*)(lds + 131328);
    LAS int* hist = (LAS int*)(lds + 131328 + 12288);
    const float* w_router = p.in[19]; const float* b_router = p.in[20];
    float breg[64];
#pragma unroll
    for (int s = 0; s < 64; ++s) breg[s] = w_router[(size_t)(128 * wave + 2 * s + (lane >> 5)) * 32 + (lane & 31)];
    const float* x = p.in[0]; const float* wpost = p.in[7]; const float* wfpre = p.in[8];
    const float* mod = (const float*)(p.ws + WS_MOD); const bf16_t* YL = (const bf16_t*)(p.ws + WS_YL); unsigned char* HL2 = p.ws + WS_HL;
    int* top_e = (int*)(p.ws + WS_TOPE); float* top_w = (float*)(p.ws + WS_TOPW); int* cntWG = (int*)(p.ws + WS_CNT);
    u32x2 yrg[4][4]; f32x4 xrg[4][4];
#define PO_LOADG(tok0_) do { _Pragma("unroll") for (int tt_ = 0; tt_ < 4; ++tt_) { const u32x2* yrow_ = (const u32x2*)(YL + (size_t)((tok0_) + tt_) * D); const f32x4* xrow_ = (const f32x4*)(x + (size_t)((tok0_) + tt_) * D); \
        _Pragma("unroll") for (int j_ = 0; j_ < 4; ++j_) { yrg[tt_][j_] = __builtin_nontemporal_load(yrow_ + lane + 64 * j_); xrg[tt_][j_] = __builtin_nontemporal_load(xrow_ + lane + 64 * j_); } } } while (0)
    if ((int)blockIdx.x < 256) PO_LOADG(blockIdx.x * 128 + wave * 4);
    for (int blk = blockIdx.x; blk < 256; blk += gridDim.x) {
        const float* mb = mod + (blk >> 4) * 6144;
        for (int i = tid; i < 1024; i += 512) { vec[i] = mb[2048 + i] * wpost[i]; vec[1024 + i] = wfpre[i] * (1.0f + mb[4096 + i]); vec[2048 + i] = mb[3072 + i]; }
        if (tid < 32) hist[tid] = 0;
        __syncthreads();
#pragma unroll 1
        for (int g = 0; g < 4; ++g) {
#pragma unroll
            for (int tt = 0; tt < 4; ++tt) {
                const int tl = wave * 4 + tt, tok = blk * 128 + g * 32 + tl;
                u32x2* orow = (u32x2*)(p.ws + WS_X1B) + (size_t)tok * (D / 4);
                f32x4 yv[4], xv[4]; float ss = 0.f;
#pragma unroll
                for (int j = 0; j < 4; ++j) { const u32x2 yr = yrg[tt][j]; yv[j] = (f32x4){bf_lo(yr.x), bf_hi(yr.x), bf_lo(yr.y), bf_hi(yr.y)}; xv[j] = xrg[tt][j];
                    ss += yv[j].x * yv[j].x + yv[j].y * yv[j].y + yv[j].z * yv[j].z + yv[j].w * yv[j].w; }
                ss = wave_sum(ss); const float rstd = rsqrtf(ss * (1.0f / D) + EPS);
                float ss2 = 0.f;
#pragma unroll
                for (int j = 0; j < 4; ++j) { const f32x4 gw = *(const LAS f32x4*)(vec + 4 * lane + 256 * j);
#pragma unroll
                    for (int i = 0; i < 4; ++i) { xv[j][i] = xv[j][i] + gw[i] * (yv[j][i] * rstd); ss2 += xv[j][i] * xv[j][i]; }
                    { u32x2 xo; xo.x = cvt_pk_bf16(xv[j][0], xv[j][1]); xo.y = cvt_pk_bf16(xv[j][2], xv[j][3]); __builtin_nontemporal_store(xo, orow + lane + 64 * j); } }
                ss2 = wave_sum(ss2); const float rstd2 = rsqrtf(ss2 * (1.0f / D) + EPS);
#pragma unroll
                for (int j = 0; j < 4; ++j) { const f32x4 a2 = *(const LAS f32x4*)(vec + 1024 + 4 * lane + 256 * j), s2 = *(const LAS f32x4*)(vec + 2048 + 4 * lane + 256 * j);
                    LAS float* trow = tile + tl * TP + 4 * lane + 256 * j;
#pragma unroll
                    for (int i = 0; i < 4; ++i) { yv[j][i] = xv[j][i] * rstd2 * a2[i] + s2[i]; trow[i] = yv[j][i]; }
                    *(unsigned*)(HL2 + (size_t)tok * D + 4 * lane + 256 * j) = pk_fp8x4(yv[j][0], yv[j][1], yv[j][2], yv[j][3]); }
            }
            __syncthreads();
            { const int ng = g + 1, nblk = ng < 4 ? blk : blk + (int)gridDim.x; if (nblk < 256) PO_LOADG(nblk * 128 + (ng & 3) * 32 + wave * 4); }
            f32x16 acc;
#pragma unroll
            for (int r = 0; r < 16; ++r) acc[r] = 0.f;
            { const LAS float* ap = tile + (lane & 31) * TP + 128 * wave + (lane >> 5);
#pragma unroll
                for (int s = 0; s < 64; ++s) acc = __builtin_amdgcn_mfma_f32_32x32x2f32(ap[2 * s], breg[s], acc, 0, 0, 0); }
            __syncthreads();
#pragma unroll
            for (int r = 0; r < 16; ++r) tile[(wave * 32 + (r & 3) + 8 * (r >> 2) + 4 * (lane >> 5)) * 32 + (lane & 31)] = acc[r];
            __syncthreads();
#pragma unroll
            for (int rr = 0; rr < 2; ++rr) { const int o = tid + 512 * rr; float sa = b_router[o & 31];
#pragma unroll
                for (int w8 = 0; w8 < 8; ++w8) sa += tile[w8 * 1024 + o];
                tile[8192 + (o >> 5) * 33 + (o & 31)] = sa; }
            __syncthreads();
#pragma unroll 1
            for (int tt = 0; tt < 4; ++tt) {
                const int tl = wave * 4 + tt, tok = blk * 128 + g * 32 + tl;
                const int ci = lane >> 1; float cv = tile[8192 + tl * 33 + ci];
                float tv[4]; int ti[4];
#pragma unroll
                for (int k = 0; k < 4; ++k) { float bv = cv; int bi = ci;
#pragma unroll
                    for (int o = 1; o < 64; o <<= 1) { const float ov = __shfl_xor(bv, o); const int oi = __shfl_xor(bi, o); const bool take = (ov > bv) || (ov == bv && oi < bi); bv = take ? ov : bv; bi = take ? oi : bi; }
                    tv[k] = bv; ti[k] = bi; cv = (ci == bi) ? -3.0e38f : cv; }
                const float e1 = __expf(tv[1] - tv[0]), e2 = __expf(tv[2] - tv[0]), e3 = __expf(tv[3] - tv[0]); const float inv = 1.0f / (1.0f + e1 + e2 + e3);
                if (lane == 0) { *(int4*)(top_e + (size_t)tok * 4) = make_int4(ti[0], ti[1], ti[2], ti[3]); *(f32x4*)(top_w + (size_t)tok * 4) = (f32x4){inv, e1 * inv, e2 * inv, e3 * inv};
#pragma unroll
                    for (int k = 0; k < 4; ++k) __hip_atomic_fetch_add(&hist[ti[k]], 1, __ATOMIC_RELAXED, __HIP_MEMORY_SCOPE_WORKGROUP); }
            }
            __syncthreads();
        }
        if (tid < 32) cntWG[blk * 32 + tid] = hist[tid];
        __syncthreads();
    }
}

__device__ __forceinline__ void ph_scatter(const Params& p, LAS unsigned char* lds) {
    const int tid = otid(), lane = tid & 63, wave = __builtin_amdgcn_readfirstlane(tid >> 6);
    LAS int* sm = (LAS int*)lds;
    const int* cntWG = (const int*)(p.ws + WS_CNT); const int* top_e = (const int*)(p.ws + WS_TOPE); const float* top_w = (const float*)(p.ws + WS_TOPW);
    int* dest_arr = (int*)(p.ws + WS_DEST); float* pw = (float*)(p.ws + WS_PW); int* tab = (int*)(p.ws + WS_TAB);
    int* ptok = (int*)(p.ws + WS_PTOK);
    for (int blk = blockIdx.x; blk < 256; blk += gridDim.x) {
        if (tid < 32) { int tot = 0, bef = 0; for (int w = 0; w < 256; ++w) { const int c = cntWG[w * 32 + tid]; tot += c; bef += (w < blk) ? c : 0; } sm[tid] = tot; sm[32 + tid] = bef; }
        __syncthreads();
        if (tid == 0) { int run = 0; for (int e = 0; e < 32; ++e) { sm[96 + e] = run; sm[64 + e] = run + sm[32 + e]; run += (sm[e] + 255) & ~255; } if (blk == 0) tab[0] = run >> 8; }
        __syncthreads();
        if (blk == 0 && tid < 32) { const int b0 = sm[96 + tid] >> 8, nb = (sm[tid] + 255) >> 8; for (int i = 0; i < nb; ++i) tab[1 + b0 + i] = tid;
            for (int i = sm[tid]; i < nb * 256; ++i) ptok[sm[96 + tid] + i] = 0; }
        const int tok = blk * 128 + (tid >> 2), k = tid & 3;
        const int e = top_e[(size_t)tok * 4 + k];
        int rank = 0;
        for (int ee = 0; ee < 32; ++ee) { const unsigned long long mask = __ballot(e == ee); if (e == ee) rank = __popcll(mask & ((1ull << lane) - 1ull)); if (lane == 0) sm[128 + wave * 32 + ee] = __popcll(mask); }
        __syncthreads();
        int off = 0; for (int w = 0; w < wave; ++w) off += sm[128 + w * 32 + e];
        const int dest = sm[64 + e] + off + rank;
        dest_arr[(size_t)tok * 4 + k] = dest; pw[dest] = top_w[(size_t)tok * 4 + k]; ptok[dest] = tok;
        __syncthreads();
    }
}

__device__ __forceinline__ void ph_combine(const Params& p) {
    const int tid = otid(), lane = tid & 63, wave = __builtin_amdgcn_readfirstlane(tid >> 6);
    const bf16_t* YB = (const bf16_t*)(p.ws + WS_YB); const int* dest_arr = (const int*)(p.ws + WS_DEST); const float* mod = (const float*)(p.ws + WS_MOD); const float* wpost2 = p.in[9];
    const int gw = blockIdx.x * 8 + wave, NGW = gridDim.x * 8;
    for (int tok = gw; tok < NTOK; tok += NGW) {
        const int b = tok >> 11; const float* g2 = mod + b * 6144 + 5120;
        const int4 dd = *(const int4*)(dest_arr + (size_t)tok * 4); const int ds[4] = {dd.x, dd.y, dd.z, dd.w};
        float y[2][8];
#pragma unroll
        for (int s = 0; s < 2; ++s)
#pragma unroll
            for (int i = 0; i < 8; ++i) y[s][i] = 0.f;
#pragma unroll
        for (int k = 0; k < 4; ++k)
#pragma unroll
            for (int s = 0; s < 2; ++s) { const u32x4 r = __builtin_nontemporal_load((const u32x4*)(YB + (size_t)ds[k] * D + s * 512 + lane * 8)); float f[8]; unpack8(r, f);
#pragma unroll
                for (int i = 0; i < 8; ++i) y[s][i] += f[i]; }
        float ss = 0.f;
#pragma unroll
        for (int s = 0; s < 2; ++s)
#pragma unroll
            for (int i = 0; i < 8; ++i) ss += y[s][i] * y[s][i];
        ss = wave_sum(ss); const float rstd = rsqrtf(ss * (1.0f / D) + EPS);
#pragma unroll
        for (int s = 0; s < 2; ++s)
#pragma unroll
            for (int q = 0; q < 2; ++q) { const int ci = s * 512 + lane * 8 + 4 * q; float* op = p.out + (size_t)tok * D + ci;
                const u32x2 xr = __builtin_nontemporal_load((const u32x2*)((const bf16_t*)(p.ws + WS_X1B) + (size_t)tok * D + ci)); const f32x4 x1 = (f32x4){bf_lo(xr.x), bf_hi(xr.x), bf_lo(xr.y), bf_hi(xr.y)};
                const f32x4 gv = *(const f32x4*)(g2 + ci), wv = *(const f32x4*)(wpost2 + ci); f32x4 o;
#pragma unroll
                for (int i = 0; i < 4; ++i) o[i] = x1[i] + gv[i] * (y[s][4 * q + i] * rstd * wv[i]);
                __builtin_nontemporal_store(o, (f32x4*)op); }
    }
}

#define XB_TMO      128
#define XB_XCNT(j)  (256  + 64 * (j))
#define XB_XSUB(j)  (1280 + 64 * (j))
#define XB_XGEN(j)  (2304 + 64 * (j))
#define XB_TOP      3328
#define XB_TOPGEN   3392
#define XCD_BAR_WORDS 3456
#define XB_SPIN_CAP (1u << 18)
__device__ __forceinline__ unsigned xb_ld(unsigned* p)              { return __hip_atomic_load(p, __ATOMIC_RELAXED, __HIP_MEMORY_SCOPE_AGENT); }
__device__ __forceinline__ unsigned xb_add(unsigned* p, unsigned v) { return __hip_atomic_fetch_add(p, v, __ATOMIC_RELAXED, __HIP_MEMORY_SCOPE_AGENT); }
__device__ __forceinline__ unsigned xb_xcc_id() { return (unsigned)__builtin_amdgcn_s_getreg((3 << 11) | 20) & 0xFu; }
#define XB_SPIN(cond, bar) do { unsigned _sp = 0; while (cond) { __builtin_amdgcn_s_sleep(1); \
    if ((++_sp & 255u) == 0u) { if (xb_ld(&(bar)[XB_TMO])) break; if (_sp > XB_SPIN_CAP) { atomicAdd(&(bar)[XB_TMO], 1u); break; } } } } while (0)
struct XcdBarrier { unsigned* bar; unsigned x; volatile LAS unsigned* st; };
__device__ __forceinline__ XcdBarrier xcd_barrier_post(unsigned* bar, volatile LAS unsigned* st) {
    XcdBarrier b; b.bar = bar; b.x = xb_xcc_id(); b.st = st;
    if (threadIdx.x == 0) (void)xb_add(&bar[XB_XCNT(b.x)], 1u);
    return b;
}
__device__ __forceinline__ void xcd_barrier_complete(unsigned* bar, unsigned x, unsigned& nloc, unsigned& nx) {
    const unsigned G = gridDim.x * gridDim.y * gridDim.z;
    unsigned sum, cnt, mine, sp = 0u;
    for (;;) {
        sum = 0u; cnt = 0u; mine = 0u;
#pragma unroll
        for (unsigned j = 0; j < 16; ++j) { const unsigned c = xb_ld(&bar[XB_XCNT(j)]); sum += c; cnt += (c > 0u) ? 1u : 0u; mine = (j == x) ? c : mine; }
        if (sum == G) break;
        __builtin_amdgcn_s_sleep(1);
        if ((++sp & 255u) == 0u) { if (xb_ld(&bar[XB_TMO])) break; if (sp > XB_SPIN_CAP) { atomicAdd(&bar[XB_TMO], 1u); break; } }
    }
    nloc = mine > 0u ? mine : 1u; nx = cnt > 0u ? cnt : 1u;
}
__device__ __forceinline__ void xcd_barrier(const XcdBarrier& b) {
    asm volatile("s_waitcnt vmcnt(0)" ::: "memory");
    __syncthreads();
    if (threadIdx.x == 0) {
        unsigned* bar = b.bar;
        __builtin_amdgcn_s_waitcnt(0);
        unsigned nloc = b.st[0], nx = b.st[1];
        if (nloc == 0u) { xcd_barrier_complete(bar, b.x, nloc, nx); b.st[0] = nloc; b.st[1] = nx; }
        const unsigned old = xb_add(&bar[XB_XSUB(b.x)], 1u);
        const unsigned gen = old / nloc;
        if (old + 1u == (gen + 1u) * nloc) {
            __builtin_amdgcn_fence(__ATOMIC_RELEASE, "agent");
            asm volatile("s_waitcnt vmcnt(0)" ::: "memory");
            const unsigned og = xb_add(&bar[XB_TOP], 1u);
            const unsigned tg = og / nx;
            if (og + 1u == (tg + 1u) * nx) xb_add(&bar[XB_TOPGEN], 1u);
            else XB_SPIN(xb_ld(&bar[XB_TOPGEN]) == tg, bar);
            __builtin_amdgcn_fence(__ATOMIC_ACQUIRE, "agent");
            xb_add(&bar[XB_XGEN(b.x)], 1u);
            asm volatile("s_waitcnt vmcnt(0)" ::: "memory");
        } else {
            XB_SPIN(xb_ld(&bar[XB_XGEN(b.x)]) == gen, bar);
            __builtin_amdgcn_fence(__ATOMIC_ACQUIRE, "agent");
            asm volatile("s_waitcnt vmcnt(0)" ::: "memory");
        }
    }
    __syncthreads();
}

typedef const __attribute__((address_space(4))) Params* KParams;
__device__ __forceinline__ Params load_params() {
    Params q{};
#if defined(__HIP_DEVICE_COMPILE__)
    KParams kp = (KParams)__builtin_amdgcn_kernarg_segment_ptr(); asm volatile("" : "+s"(kp));
#pragma unroll
    for (int i = 0; i < 25; ++i) q.in[i] = kp->in[i];
    q.out = kp->out; q.ws = kp->ws; q.ph_lo = kp->ph_lo; q.ph_hi = kp->ph_hi;
#endif
    return q;
}
__global__ void __launch_bounds__(512, 2) mega_fwd(Params pk) {
    extern __shared__ __attribute__((aligned(16))) unsigned char lds_raw[];
    LAS unsigned char* lds = (LAS unsigned char*)lds_raw;
    cg::grid_group grid = cg::this_grid();
    const int G = gridDim.x, c = blockIdx.x;
#ifndef PHASE_MASK
#define PHASE_MASK 0x3fff
#endif
#define IN(k) (((PHASE_MASK >> (k)) & 1) && pk.ph_lo <= (k) && (k) < pk.ph_hi)
    volatile LAS unsigned* bst = (volatile LAS unsigned*)(lds + LDS_BYTES - 16);
    if (threadIdx.x < 2) bst[threadIdx.x] = 0u;
    __syncthreads();
    const XcdBarrier xbar = xcd_barrier_post((unsigned*)(pk.ws + WS_BAR), bst);
#define SEAM(k) do { if ((k) + 1 < pk.ph_hi) { if ((k) == 0) grid.sync(); else xcd_barrier(xbar); } } while (0)
#ifndef PROBE_PHASE
#define PROBE_PHASE -1
#define PROBE_REPS 1
#endif
#define NREP(k) ((k) == PROBE_PHASE ? PROBE_REPS : 1)
    for (int rep_ = 0; rep_ < NREP(0); ++rep_) if (IN(0)) { const Params p = load_params(); ph_setup(p, lds); SEAM(0); }
    for (int rep_ = 0; rep_ < NREP(1); ++rep_) if (IN(1)) { const Params p = load_params(); ph_hl(p, lds); SEAM(1); }
    for (int rep_ = 0; rep_ < NREP(2); ++rep_) if (IN(2)) { const Params p = load_params(); pg8::Gemm g{(const bf16_t*)(p.ws + WS_HL), (const bf16_t*)(p.ws + WS_WIN), D}; pg8::OrderP S{G, c};
        pg8::EpiP E{(bf16_t*)(p.ws + WS_PD), (bf16_t*)(p.ws + WS_PL), p.in[11], p.in[13]}; pg8::gemm_phase(lds, g, S, E); SEAM(2); }
    for (int rep_ = 0; rep_ < NREP(3); ++rep_) if (IN(3)) { const Params p = load_params(); ph_prep(p, lds); SEAM(3); }
    for (int rep_ = 0; rep_ < NREP(4); ++rep_) if (IN(4)) { const Params p = load_params(); ph_scan2(p, lds); SEAM(4); }
    for (int rep_ = 0; rep_ < NREP(5); ++rep_) if (IN(5)) { const Params p = load_params(); ph_merge(p); SEAM(5); }
    for (int rep_ = 0; rep_ < NREP(6); ++rep_) if (IN(6)) { const Params p = load_params(); pg8::Gemm g{(const bf16_t*)(p.ws + WS_AB), (const bf16_t*)(p.ws + WS_WPAB), 512}; pg8::OrderY S{G, c};
        pg8::EpiY E{(bf16_t*)(p.ws + WS_Y), (const bf16_t*)(p.ws + WS_PL)}; pg8::gemm_phase(lds, g, S, E); SEAM(6); }
    for (int rep_ = 0; rep_ < NREP(8); ++rep_) if (IN(8)) { const Params p = load_params(); pg8::Gemm g{(const bf16_t*)(p.ws + WS_Y), (const bf16_t*)(p.ws + WS_WOUT), D}; pg8::StaticOrder S{NTOK / 256, 4, G, c};
        pg8::EpiBf E{(bf16_t*)(p.ws + WS_YL), D}; pg8::gemm_phase(lds, g, S, E); SEAM(8); }
    for (int rep_ = 0; rep_ < NREP(9); ++rep_) if (IN(9)) { const Params p = load_params(); ph_post(p, lds); SEAM(9); }
    for (int rep_ = 0; rep_ < NREP(10); ++rep_) if (IN(10)) { const Params p = load_params(); ph_scatter(p, lds); __syncthreads(); ph_wexp(p, lds); SEAM(10); }
    for (int rep_ = 0; rep_ < NREP(11); ++rep_) if (IN(11)) { const Params p = load_params();
        LAS int* tab = (LAS int*)(lds + LDS_STAGE); const int* gtab = (const int*)(p.ws + WS_TAB);
        for (int i = otid(); i < 1 + MAXBLK; i += 512) tab[i] = gtab[i];
        __syncthreads();
        pg8::Gemm g{(const bf16_t*)(p.ws + WS_HL), (const bf16_t*)(p.ws + WS_WGU), D / 2}; pg8::OrderMoe<true> S{G, c, 8, tab, (const int*)(p.ws + WS_PTOK)};
        pg8::EpiAct E{p.ws + WS_ACT, p.in[22]}; pg8::gemm_phase(lds, g, S, E); SEAM(11); }
    for (int rep_ = 0; rep_ < NREP(12); ++rep_) if (IN(12)) { const Params p = load_params();
        LAS int* tab = (LAS int*)(lds + LDS_STAGE); const int* gtab = (const int*)(p.ws + WS_TAB);
        for (int i = otid(); i < 1 + MAXBLK; i += 512) tab[i] = gtab[i];
        __syncthreads();
        pg8::Gemm g{(const bf16_t*)(p.ws + WS_ACT), (const bf16_t*)(p.ws + WS_WDN), D / 2}; pg8::OrderMoe<false> S{G, c, 4, tab, nullptr};
        pg8::EpiDown E{(bf16_t*)(p.ws + WS_YB), p.in[24], (const float*)(p.ws + WS_PW)}; pg8::gemm_phase(lds, g, S, E); SEAM(12); }
    for (int rep_ = 0; rep_ < NREP(13); ++rep_) if (IN(13)) { const Params p = load_params(); ph_combine(p); }
#undef IN
#undef SEAM
}

#ifndef N_LAUNCH_MODE
#define N_LAUNCH_MODE 1
#endif

extern "C" void kernel_launch(void* const* d_in, const int* in_sizes, int n_in, void* d_out, int out_size, void* d_ws, size_t ws_size, hipStream_t stream) {
    static int grid_blocks = 0;
    if (grid_blocks == 0) {
        if (n_in != 25 || ws_size < WS_END) { fprintf(stderr, "kernel_launch: unexpected n_in %d or ws_size %zu (< %zu)\n", n_in, ws_size, (size_t)WS_END); grid_blocks = -1; return; }
        int dev = 0, cus = 0, per_cu = 0;
        hipGetDevice(&dev);
        hipDeviceGetAttribute(&cus, hipDeviceAttributeMultiprocessorCount, dev);
        hipFuncSetAttribute((const void*)mega_fwd, hipFuncAttributeMaxDynamicSharedMemorySize, LDS_BYTES);
        hipOccupancyMaxActiveBlocksPerMultiprocessor(&per_cu, (const void*)mega_fwd, 512, LDS_BYTES);
        if (per_cu < 1) { fprintf(stderr, "kernel_launch: occupancy query says %d blocks/CU\n", per_cu); per_cu = 1; }
        if (per_cu > 1) per_cu = 1;
        grid_blocks = cus * per_cu;
    }
    if (grid_blocks < 0) return;
    if (hipMemsetAsync((char*)d_ws + WS_BAR, 0, 16384, stream) != hipSuccess) { fprintf(stderr, "kernel_launch: memset of the barrier words failed\n"); return; }
    Params p{};
    for (int i = 0; i < 25; ++i) p.in[i] = (const float*)d_in[i];
    p.out = (float*)d_out; p.ws = (unsigned char*)d_ws;
#if N_LAUNCH_MODE == 1
    p.ph_lo = 0; p.ph_hi = NPHASE;
    { void* args[] = {&p}; hipError_t e = hipLaunchCooperativeKernel((const void*)mega_fwd, dim3(grid_blocks), dim3(512), args, LDS_BYTES, stream);
      if (e != hipSuccess) fprintf(stderr, "cooperative launch failed: %s (grid %d)\n", hipGetErrorString(e), grid_blocks); }
#else
    for (int ph = 0; ph < NPHASE; ++ph) {
        p.ph_lo = ph; p.ph_hi = ph + 1;
        void* args[] = {&p}; hipError_t e = hipLaunchCooperativeKernel((const void*)mega_fwd, dim3(grid_blocks), dim3(512), args, LDS_BYTES, stream);
        if (e != hipSuccess) { fprintf(stderr, "cooperative launch (phase %d) failed: %s (grid %d)\n", ph, hipGetErrorString(e), grid_blocks); break; }
    }
#endif
}
```

```cpp
#include <hip/hip_runtime.h>
#include <hip/hip_cooperative_groups.h>
#include <cstdio>
namespace cg = cooperative_groups;

#define LAS __attribute__((address_space(3)))
typedef unsigned short bf16_t;
typedef short bf16x8 __attribute__((ext_vector_type(8)));
typedef float f32x4 __attribute__((ext_vector_type(4)));
typedef float f32x2 __attribute__((ext_vector_type(2)));
typedef unsigned u32x4 __attribute__((ext_vector_type(4)));
typedef unsigned u32x2 __attribute__((ext_vector_type(2)));
typedef int i32x4 __attribute__((ext_vector_type(4)));
typedef int i32x8 __attribute__((ext_vector_type(8)));

constexpr int D = 1024, NB = 16, T = 2048, TC = 256;
constexpr int NTOK = NB * T, NCTX = NB * TC, MROWS = NTOK + NCTX;
constexpr int NIN = 6672, NP = 6656;
constexpr int C_MQ = 0, C_MK = 512, C_MV = 1024, C_MO = 1536, C_HQ = 2048, C_HI = 2560, C_HG = 3072, C_HF = 3584, C_GA = 4608, C_GB = 5632, C_MG = 6656;
constexpr int NE = 32, TOPK = 4, PMAX = NTOK * TOPK + NE * 256, MAXBLK = PMAX / 256;
constexpr float EPS = 1e-6f;
constexpr int NPHASE = 14;
constexpr int LDS_STAGE = 131072, LDS_BYTES = LDS_STAGE + 16384;
constexpr float F8_WSCALE = 32.0f, F8_ASCALE = 4.0f, F8_YSCALE = 8.0f;

constexpr size_t al256(size_t x) { return (x + 255) & ~(size_t)255; }
constexpr size_t SZ_T = (size_t)NB * 4 * 128 * 2304 * 2;
constexpr size_t SZ_N = (size_t)NTOK * 512 * 2;
constexpr size_t SZ_ST = (size_t)NB * 4 * 2 * 32 * 128 * 128 * 2;
constexpr int PD_W = 3584, PL_W = 3072;
constexpr int PD_MQ = 0, PD_MK = 512, PD_MV = 1024, PD_HQ = 1536, PD_HI = 2048, PD_HF = 2560;
constexpr int PL_MO = 0, PL_HG = 512, PL_GA = 1024, PL_GB = 2048;
constexpr int NBHD = NB * 4 * 2;
constexpr size_t WS_WIN = 0;
constexpr size_t WS_WPAB = WS_WIN + (size_t)NP * D * 2;
constexpr size_t WS_WOUT = WS_WPAB + (size_t)D * D * 2;
constexpr size_t WS_MOD = WS_WOUT + (size_t)D * D * 2;
constexpr size_t WS_MG = al256(WS_MOD + 17 * 6144 * 4);
constexpr size_t WS_TOPE = al256(WS_MG + (size_t)MROWS * 16 * 4);
constexpr size_t WS_TOPW = WS_TOPE + (size_t)NTOK * 4 * 4;
constexpr size_t WS_DEST = WS_TOPW + (size_t)NTOK * 4 * 4;
constexpr size_t WS_PW = WS_DEST + (size_t)NTOK * 4 * 4;
constexpr size_t WS_PTOK = al256(WS_PW + (size_t)PMAX * 4);
constexpr size_t WS_CNT = al256(WS_PTOK + (size_t)PMAX * 4);
constexpr size_t WS_TAB = WS_CNT + 256 * 32 * 4;
constexpr size_t WS_BAR = WS_TAB + 4096;
constexpr size_t WS_GW = WS_BAR + 16384;
constexpr size_t WS_G1 = WS_GW + (size_t)NBHD * 2304 * 4;
constexpr size_t WS_WB = WS_G1 + (size_t)NBHD * 2304 * 4;
constexpr size_t WS_DEC = WS_WB + (size_t)NBHD * 2304 * 2;
constexpr size_t WS_EAL = al256(WS_DEC + (size_t)NBHD * 36 * 4);
constexpr size_t WS_NS = WS_EAL + (size_t)NBHD * 36 * 128 * 4;
constexpr size_t WS_HL = al256(WS_NS + (size_t)NBHD * 32 * 128 * 4);
constexpr size_t WS_QK = WS_HL;
constexpr size_t WS_RW = WS_HL + (size_t)MROWS * D * 2;
constexpr size_t WS_WGU = WS_RW;
constexpr size_t WS_WDN = WS_WGU + (size_t)NE * 2048 * D * 2;
constexpr size_t WS_KEFN = WS_RW, WS_KEBN = WS_RW + SZ_N, WS_QPFN = WS_RW + 2 * SZ_N, WS_QPBN = WS_RW + 3 * SZ_N;
constexpr size_t WS_AB = WS_RW + 4 * SZ_N;
constexpr size_t WS_RPD = WS_WDN + (size_t)NE * D * D * 2;
constexpr size_t WS_PD = WS_RPD;
constexpr size_t WS_HS = WS_RPD;
constexpr size_t WS_YL = WS_RPD;
constexpr size_t WS_RT = WS_RPD + 2 * SZ_ST;
constexpr size_t WS_KT = WS_RT, WS_VTF = WS_RT + SZ_T, WS_VTB = WS_RT + 2 * SZ_T, WS_KEFT = WS_RT + 3 * SZ_T, WS_KEBT = WS_RT + 4 * SZ_T, WS_IT = WS_RT + 5 * SZ_T;
constexpr size_t WS_Y = WS_RT;
constexpr size_t WS_RPL = WS_RT + 6 * SZ_T;
constexpr size_t WS_PL = WS_RPL;
constexpr size_t WS_XB = WS_RPD;
constexpr size_t WS_ACT = WS_XB + (size_t)PMAX * D * 2;
constexpr size_t WS_YB = WS_XB;
constexpr size_t WS_X1B = WS_ACT + (size_t)PMAX * D * 2;
constexpr size_t WS_END1 = WS_RPL + (size_t)NTOK * PL_W * 2;
constexpr size_t WS_END2 = WS_X1B + (size_t)NTOK * D * 2;
constexpr size_t WS_END = WS_END1 > WS_END2 ? WS_END1 : WS_END2;
static_assert((size_t)MROWS * PD_W * 2 <= 2 * SZ_ST, "P_dead must fit its region");
static_assert(WS_AB + (size_t)NTOK * D * 2 <= WS_RPD, "AB must fit the expert-weight region");
static_assert(WS_END <= (size_t)4 * 268435456, "workspace too large");

struct Params { const float* in[25]; float* out; unsigned char* ws; int ph_lo, ph_hi; };

__device__ __forceinline__ int otid() { int t = threadIdx.x; asm volatile("" : "+v"(t)); return t; }
__device__ __forceinline__ unsigned cvt_pk_bf16(float lo, float hi) { unsigned r; asm volatile("v_cvt_pk_bf16_f32 %0, %1, %2" : "=v"(r) : "v"(lo), "v"(hi)); return r; }
__device__ __forceinline__ unsigned pk_fp8x4(float a, float b, float c, float d) {
    unsigned w; asm volatile("v_cvt_pk_fp8_f32 %0, %1, %2" : "=v"(w) : "v"(a), "v"(b)); asm volatile("v_cvt_pk_fp8_f32 %0, %1, %2 op_sel:[0,0,1]" : "+v"(w) : "v"(c), "v"(d)); return w; }
__device__ __forceinline__ float bf_lo(unsigned w) { return __uint_as_float(w << 16); }
__device__ __forceinline__ float bf_hi(unsigned w) { return __uint_as_float(w & 0xffff0000u); }
__device__ __forceinline__ float sigmoidf_(float x) { return __builtin_amdgcn_rcpf(1.0f + __builtin_amdgcn_exp2f(-1.4426950408889634f * x)); }
__device__ __forceinline__ float siluf_(float x) { return x * __builtin_amdgcn_rcpf(1.0f + __builtin_amdgcn_exp2f(-1.4426950408889634f * x)); }
__device__ __forceinline__ float wave_sum(float v) {
#pragma unroll
    for (int o = 1; o < 64; o <<= 1) v += __shfl_xor(v, o);
    return v;
}
__device__ __forceinline__ void unpack8(const u32x4 w, float (&f)[8]) {
    f[0] = bf_lo(w.x); f[1] = bf_hi(w.x); f[2] = bf_lo(w.y); f[3] = bf_hi(w.y); f[4] = bf_lo(w.z); f[5] = bf_hi(w.z); f[6] = bf_lo(w.w); f[7] = bf_hi(w.w);
}
__device__ __forceinline__ u32x4 pack8(const float (&f)[8]) {
    u32x4 w; w.x = cvt_pk_bf16(f[0], f[1]); w.y = cvt_pk_bf16(f[2], f[3]); w.z = cvt_pk_bf16(f[4], f[5]); w.w = cvt_pk_bf16(f[6], f[7]); return w;
}

namespace pg8 {
constexpr int BM = 256, BK = 64, HALF = 128, HTB = HALF * BK * 2, STAGE_BYTES = 8 * HTB, NXCD = 8, WGM = 8;
__device__ __forceinline__ int lds_byte(int r, int c) { const int st = (r >> 4) * 2 + (c >> 5), rr = r & 15, cc = c & 31, ob = rr * 64 + cc * 2; return st * 1024 + (ob ^ (((ob >> 9) & 1) << 5)); }
__device__ __forceinline__ void stage_rc(int b, int& R, int& C) { const int st = b / 1024, sb = b % 1024, swz = sb ^ (((sb >> 9) & 1) << 5); R = (st >> 1) * 16 + swz / 64; C = (st & 1) * 32 + (swz % 64) / 2; }
__device__ __forceinline__ int perm32(int rho) { const int n = rho >> 4, i = rho & 15; return 8 * (i >> 2) + 4 * n + (i & 3); }

struct Unit { int pm, pn, pb, e, pa; };
struct Gemm { const bf16_t* A; const bf16_t* Bt; int K; };

__device__ __forceinline__ void static_map(int wgid, int nM, int nN, int& pm, int& pn) {
    const int nwg = nM * nN;
    { const int q = nwg / NXCD, r = nwg % NXCD, xcd = wgid % NXCD, off = wgid / NXCD; wgid = (xcd < r ? xcd * (q + 1) : r * (q + 1) + (xcd - r) * q) + off; }
    const int nig = WGM * nN, gid = wgid / nig, fm = gid * WGM, gsz = (nM - fm) < WGM ? (nM - fm) : WGM;
    pm = fm + ((wgid % nig) % gsz); pn = (wgid % nig) / gsz;
}
struct StaticOrder {
    static constexpr bool GATHER = false;
    int nM, nN, G, c;
    __device__ __forceinline__ bool next(int i, Unit& u) const {
        const int L = i * G + c; if (L >= nM * nN) return false;
        static_map(L, nM, nN, u.pm, u.pn); u.pb = u.pn; u.e = 0; u.pa = u.pm; return true;
    }
};
struct OrderP {
    static constexpr bool GATHER = false;
    int G, c;
    __device__ __forceinline__ bool next(int i, Unit& u) const {
        const int L = i * G + c;
        if (L < 128 * 26) { static_map(L, 128, 26, u.pm, u.pn); }
        else { const int r = L - 128 * 26; if (r >= 160) return false; const int q = r >> 4; u.pm = 128 + (r & 15); u.pn = q < 4 ? 2 + q : (q < 6 ? 6 + q : 8 + q); }
        u.pb = u.pn; u.e = 0; u.pa = u.pm; return true;
    }
};
struct OrderY {
    static constexpr bool GATHER = false;
    int G, c;
    __device__ __forceinline__ bool next(int i, Unit& u) const {
        const int L = (i >> 1) * G + c, which = i & 1; if (L >= (NTOK / 256) * 4) return false;
        static_map(L, NTOK / 256, 4, u.pm, u.pn); u.pa = u.pm + which * (NTOK / 256); u.pb = u.pn + which * 4; u.e = which; return true;
    }
};
template <bool GATHER_> struct OrderMoe {
    static constexpr bool GATHER = GATHER_;
    int G, c, nN; const LAS int* tab; const int* rowidx;
    __device__ __forceinline__ bool next(int i, Unit& u) const {
        int pm, pn;
        if ((G & 7) == 0 && G >= 64) { const int ppx = (G >> 3) / nN, j = c >> 3; pm = i * (8 * ppx) + (c & 7) * ppx + j / nN; pn = j % nN; }
        else { const int L = i * G + c; pm = L / nN; pn = L - pm * nN; }
        const int nblk = __builtin_amdgcn_readfirstlane(tab[0]);
        if (pm >= nblk) return false;
        const int e = __builtin_amdgcn_readfirstlane(tab[1 + pm]);
        u.pm = pm; u.pn = pn; u.pb = e * nN + pn; u.e = e; u.pa = pm; return true;
    }
};

template <class Epi, class Sched>
__device__ __forceinline__ void gemm_phase(LAS unsigned char* lds, const Gemm g, const Sched& S, const Epi& E) {
    const int tid = otid(), wid = __builtin_amdgcn_readfirstlane(tid >> 6), lane = tid & 63, wr = wid >> 2, wc = wid & 3, fr = lane & 15, fq = lane >> 4;
    const int K = g.K, nt = K / BK;
    unsigned voffB[2], vc[2][2], vn[2][2]; int Ra[2], Cb[2];
#pragma unroll
    for (int i = 0; i < 2; ++i) { int R, C; stage_rc(tid * 16 + i * 8192, R, C); const int Rb = Epi::PERM ? ((R & ~31) + perm32(R & 31)) : R;
        Ra[i] = R; Cb[i] = C * 2; voffB[i] = (unsigned)(Rb * K + C) * 2u; vc[0][i] = vc[1][i] = vn[0][i] = vn[1][i] = (unsigned)(R * K + C) * 2u; }
    LAS int* gidx = (LAS int*)(lds + STAGE_BYTES + 4096);
    LAS unsigned char* ebase = lds + STAGE_BYTES + 6144;
    const size_t kstep = (size_t)(BK * 2);
    const size_t hstep = (size_t)HALF * K * 2;
    const size_t tstep = 2 * hstep;
    const size_t hsA = Sched::GATHER ? 0 : hstep;
    const unsigned ldsw = (unsigned)wid * 1024u;
    const int aoff = lds_byte(wr * 64 + fr, fq * 8), boff = lds_byte(wc * 32 + fr, fq * 8);
#define PG8_SA(b, h) (((b) * 2 + (h)) * HTB)
#define PG8_SB(b, h) ((4 + (b) * 2 + (h)) * HTB)
#define PG8_STAGE(bufoff, gbase, voff) do { _Pragma("unroll") for (int _i = 0; _i < 2; ++_i) { unsigned _vo = (voff)[_i]; asm volatile("" : "+v"(_vo)); \
        __builtin_amdgcn_global_load_lds((const unsigned*)((const char*)(gbase) + _vo), (LAS unsigned*)(lds + (bufoff) + ldsw + _i * 8192), 16, 0, 0); } } while (0)
#define PG8_LDA(dst, b, h) do { _Pragma("unroll") for (int m = 0; m < 4; ++m) _Pragma("unroll") for (int k = 0; k < 2; ++k) dst[m][k] = *(const LAS bf16x8*)(lds + PG8_SA(b, h) + aoff + m * 2048 + k * 1024); } while (0)
#define PG8_LDB(dst, b, h) do { _Pragma("unroll") for (int n = 0; n < 2; ++n) _Pragma("unroll") for (int k = 0; k < 2; ++k) dst[n][k] = *(const LAS bf16x8*)(lds + PG8_SB(b, h) + boff + n * 2048 + k * 1024); } while (0)
#define PG8_CAT8(x) __builtin_shufflevector((i32x4)(x)[0], (i32x4)(x)[1], 0, 1, 2, 3, 4, 5, 6, 7)
#define PG8_MMA8(ai, bj, A_, B_, m, n) asm volatile("v_mfma_f32_16x16x128_f8f6f4 %0, %1, %2, %0" : "+v"(acc[ai][bj][m][n]) : "v"(PG8_CAT8(B_[n])), "v"(PG8_CAT8(A_[m])))
#define PG8_MMA_DRAIN asm volatile("s_nop 15\n\ts_nop 15" ::: "memory")
#define PG8_MMA(ai, bj, At, Bt) do { __builtin_amdgcn_s_setprio(1); \
        if constexpr (Epi::FP8) { _Pragma("unroll") for (int m = 0; m < 4; ++m) _Pragma("unroll") for (int n = 0; n < 2; ++n) PG8_MMA8(ai, bj, At, Bt, m, n); } \
        else { _Pragma("unroll") for (int m = 0; m < 4; ++m) _Pragma("unroll") for (int n = 0; n < 2; ++n) _Pragma("unroll") for (int k = 0; k < 2; ++k) \
            acc[ai][bj][m][n] = __builtin_amdgcn_mfma_f32_16x16x32_bf16(Bt[n][k], At[m][k], acc[ai][bj][m][n], 0, 0, 0); } \
        __builtin_amdgcn_s_setprio(0); } while (0)
#define PG8_WAIT_V(n) asm volatile("s_waitcnt vmcnt(" #n ")" ::: "memory")
#define PG8_WAIT_L(n) asm volatile("s_waitcnt lgkmcnt(" #n ")" ::: "memory")
#define PG8_BAR __builtin_amdgcn_s_barrier()
#define PG8_SCHED __builtin_amdgcn_sched_barrier(0)
    Unit cur, nxt; int ui = 0;
    if (!S.next(0, cur)) return;
    f32x4 acc[2][2][4][2];
#pragma unroll
    for (int a = 0; a < 2; ++a)
#pragma unroll
        for (int b = 0; b < 2; ++b)
#pragma unroll
            for (int m = 0; m < 4; ++m)
#pragma unroll
                for (int n = 0; n < 2; ++n) acc[a][b][m][n] = (f32x4){0.f, 0.f, 0.f, 0.f};
    bf16x8 At[4][2], B0[2][2], B1[2][2];
    const char* cA = Sched::GATHER ? (const char*)g.A : (const char*)g.A + (size_t)cur.pa * tstep; const char* cB = (const char*)g.Bt + (size_t)cur.pb * tstep;
    if constexpr (Sched::GATHER) {
        if (wid == 0) __builtin_amdgcn_global_load_lds((const unsigned*)(S.rowidx + (size_t)cur.pm * 256 + 4 * lane), (LAS unsigned*)gidx, 16, 0, 0);
        asm volatile("s_waitcnt vmcnt(0)" ::: "memory"); __syncthreads();
#pragma unroll
        for (int h = 0; h < 2; ++h)
#pragma unroll
            for (int i = 0; i < 2; ++i) { vc[h][i] = (unsigned)gidx[h * 128 + Ra[i]] * (unsigned)(K * 2) + (unsigned)Cb[i]; vn[h][i] = vc[h][i]; }
    }
    PG8_STAGE(PG8_SB(0, 0), cB, voffB); PG8_STAGE(PG8_SA(0, 0), cA, vc[0]); PG8_STAGE(PG8_SB(0, 1), cB + hstep, voffB); PG8_STAGE(PG8_SA(0, 1), cA + hsA, vc[1]);
    if (wr == 1) PG8_BAR;
    PG8_WAIT_V(4); PG8_BAR;
    PG8_STAGE(PG8_SB(1, 0), cB + kstep, voffB); PG8_STAGE(PG8_SA(1, 0), cA + kstep, vc[0]); PG8_STAGE(PG8_SB(1, 1), cB + hstep + kstep, voffB);
    PG8_WAIT_V(6); PG8_BAR;
    for (;;) {
        const bool has_next = S.next(ui + 1, nxt);
        E.prefetch(cur, ebase + (ui & 1) * 3072, wid, lane);
        const char* nA = Sched::GATHER ? cA : (has_next ? (const char*)g.A + (size_t)nxt.pa * tstep : cA); const char* nB = has_next ? (const char*)g.Bt + (size_t)nxt.pb * tstep : cB;
        if constexpr (Sched::GATHER) { if (has_next && wid == 0) __builtin_amdgcn_global_load_lds((const unsigned*)(S.rowidx + (size_t)nxt.pm * 256 + 4 * lane), (LAS unsigned*)(gidx + ((ui + 1) & 1) * 256), 16, 0, 0); }
        for (int t = 0; t < nt; t += 2) {
            const bool last = (t == nt - 2);
            const char* a1 = cA + (size_t)(t + 1) * kstep;
            const char* a2 = last ? nA : cA + (size_t)(t + 2) * kstep; const char* b2 = last ? nB : cB + (size_t)(t + 2) * kstep;
            const char* a3 = a2 + kstep; const char* b3 = b2 + kstep;
            if constexpr (Sched::GATHER) { if (last && has_next) {
#pragma unroll
                for (int h = 0; h < 2; ++h)
#pragma unroll
                    for (int i = 0; i < 2; ++i) vn[h][i] = (unsigned)gidx[((ui + 1) & 1) * 256 + h * 128 + Ra[i]] * (unsigned)(K * 2) + (unsigned)Cb[i]; } }
            unsigned w2[2][2];
#pragma unroll
            for (int h = 0; h < 2; ++h)
#pragma unroll
                for (int i = 0; i < 2; ++i) w2[h][i] = last ? vn[h][i] : vc[h][i];
            PG8_LDB(B0, 0, 0); PG8_SCHED; PG8_LDA(At, 0, 0); PG8_STAGE(PG8_SA(1, 1), a1 + hsA, vc[1]);
            PG8_WAIT_L(8); PG8_BAR; PG8_WAIT_L(0); PG8_MMA(0, 0, At, B0); PG8_BAR; PG8_SCHED;
            PG8_LDB(B1, 0, 1); PG8_STAGE(PG8_SB(0, 0), b2, voffB);
            PG8_BAR; PG8_WAIT_L(0); PG8_MMA(0, 1, At, B1); PG8_BAR;
            PG8_LDA(At, 0, 1); PG8_STAGE(PG8_SA(0, 0), a2, w2[0]);
            PG8_BAR; PG8_WAIT_L(0); PG8_MMA(1, 0, At, B0); PG8_BAR; PG8_SCHED;
            PG8_STAGE(PG8_SB(0, 1), b2 + hstep, voffB);
            PG8_WAIT_V(6); PG8_BAR; PG8_MMA(1, 1, At, B1); PG8_BAR;
            PG8_LDB(B0, 1, 0); PG8_SCHED; PG8_LDA(At, 1, 0); PG8_STAGE(PG8_SA(0, 1), a2 + hsA, w2[1]);
            PG8_WAIT_L(8); PG8_BAR; PG8_WAIT_L(0); PG8_MMA(0, 0, At, B0); PG8_BAR; PG8_SCHED;
            PG8_LDB(B1, 1, 1); PG8_STAGE(PG8_SB(1, 0), b3, voffB);
            PG8_BAR; PG8_WAIT_L(0); PG8_MMA(0, 1, At, B1); PG8_BAR;
            PG8_LDA(At, 1, 1); PG8_STAGE(PG8_SA(1, 0), a3, w2[0]);
            PG8_BAR; PG8_WAIT_L(0); PG8_MMA(1, 0, At, B0); PG8_BAR; PG8_SCHED;
            PG8_STAGE(PG8_SB(1, 1), b3 + hstep, voffB);
            PG8_WAIT_V(6); PG8_BAR; PG8_MMA(1, 1, At, B1); PG8_BAR;
        }
        if constexpr (Epi::FP8) PG8_MMA_DRAIN;
        bool carry = false;
        if constexpr (Epi::CARRY) { carry = E.first_pass(cur); if (carry) E.rescale(acc, cur, wr, wc, fr, fq); }
        if (!carry) E(acc, cur, wr, wc, fr, fq, ebase + (ui & 1) * 3072);
        if (!has_next) break;
        if (!carry) {
#pragma unroll
        for (int a = 0; a < 2; ++a)
#pragma unroll
            for (int b = 0; b < 2; ++b)
#pragma unroll
                for (int m = 0; m < 4; ++m)
#pragma unroll
                    for (int n = 0; n < 2; ++n) acc[a][b][m][n] = (f32x4){0.f, 0.f, 0.f, 0.f};
        }
        cur = nxt; cA = nA; cB = nB; ++ui;
#pragma unroll
        for (int h = 0; h < 2; ++h)
#pragma unroll
            for (int i = 0; i < 2; ++i) vc[h][i] = vn[h][i];
    }
    PG8_WAIT_V(0);
    if (wr == 0) PG8_BAR;
    PG8_BAR;
#undef PG8_SA
#undef PG8_SB
#undef PG8_STAGE
#undef PG8_LDA
#undef PG8_LDB
#undef PG8_MMA
#undef PG8_CAT8
#undef PG8_MMA8
#undef PG8_MMA_DRAIN
#undef PG8_WAIT_V
#undef PG8_WAIT_L
#undef PG8_BAR
#undef PG8_SCHED
}

struct EpiF32 {
    static constexpr bool PERM = false, MID = false, CARRY = false, FP8 = false;
    float* C; int ldc;
    __device__ __forceinline__ void prefetch(const Unit&, LAS unsigned char*, int, int) const {}
    __device__ __forceinline__ void operator()(const f32x4 (&acc)[2][2][4][2], const Unit& u, int wr, int wc, int fr, int fq, const LAS unsigned char*) const {
        const int row0 = u.pm * BM + wr * 64 + fr, col0 = u.pn * BM + wc * 32 + 4 * fq;
#pragma unroll
        for (int ai = 0; ai < 2; ++ai)
#pragma unroll
            for (int m = 0; m < 4; ++m) { float* rowp = C + (size_t)(row0 + ai * HALF + m * 16) * ldc + col0;
#pragma unroll
                for (int bj = 0; bj < 2; ++bj)
#pragma unroll
                    for (int n = 0; n < 2; ++n) *(f32x4*)(rowp + bj * HALF + n * 16) = acc[ai][bj][m][n]; }
    }
};
struct EpiBf {
    static constexpr bool PERM = true, MID = false, CARRY = false, FP8 = false;
    bf16_t* C; int ldc;
    __device__ __forceinline__ void prefetch(const Unit&, LAS unsigned char*, int, int) const {}
    __device__ __forceinline__ void operator()(const f32x4 (&acc)[2][2][4][2], const Unit& u, int wr, int wc, int fr, int fq, const LAS unsigned char*) const {
        const int row0 = u.pm * BM + wr * 64 + fr, col0 = u.pn * BM + wc * 32 + 8 * fq;
#pragma unroll
        for (int ai = 0; ai < 2; ++ai)
#pragma unroll
            for (int m = 0; m < 4; ++m) { bf16_t* rowp = C + (size_t)(row0 + ai * HALF + m * 16) * ldc + col0;
#pragma unroll
                for (int bj = 0; bj < 2; ++bj) { const f32x4 v0 = acc[ai][bj][m][0], v1 = acc[ai][bj][m][1];
                    u32x4 w; w.x = cvt_pk_bf16(v0[0], v0[1]); w.y = cvt_pk_bf16(v0[2], v0[3]); w.z = cvt_pk_bf16(v1[0], v1[1]); w.w = cvt_pk_bf16(v1[2], v1[3]);
                    *(u32x4*)(rowp + bj * HALF) = w; } }
    }
};
struct EpiP {
    static constexpr bool PERM = true, MID = false, CARRY = false, FP8 = false;
    bf16_t* PD; bf16_t* PL; const float* b_in; const float* lb_raw;
    __device__ __forceinline__ void prefetch(const Unit& u, LAS unsigned char* eb, int wid, int lane) const {
        if (wid == 0) __builtin_amdgcn_global_load_lds((const unsigned*)(b_in + u.pn * 256 + 4 * lane), (LAS unsigned*)eb, 16, 0, 0);
        if (u.pn >= 14 && u.pn < 18 && (wid == 1 || wid == 2))
            __builtin_amdgcn_global_load_lds((const unsigned*)(lb_raw + (wid - 1) * 1024 + (u.pn * 256 - C_HF) + 4 * lane), (LAS unsigned*)(eb + wid * 1024), 16, 0, 0);
    }
    __device__ __forceinline__ void operator()(const f32x4 (&acc)[2][2][4][2], const Unit& u, int wr, int wc, int fr, int fq, const LAS unsigned char* eb) const {
        const int pn = u.pn;
        bf16_t* base; int ldw, dcol;
        if (pn < 6) { base = PD; ldw = PD_W; dcol = pn * 256; }
        else if (pn < 8) { base = PL; ldw = PL_W; dcol = PL_MO + (pn - 6) * 256; }
        else if (pn < 12) { base = PD; ldw = PD_W; dcol = PD_HQ + (pn - 8) * 256; }
        else if (pn < 14) { base = PL; ldw = PL_W; dcol = PL_HG + (pn - 12) * 256; }
        else if (pn < 18) { base = PD; ldw = PD_W; dcol = PD_HF + (pn - 14) * 256; }
        else { base = PL; ldw = PL_W; dcol = PL_GA + (pn - 18) * 256; }
        const int row0 = u.pm * BM + wr * 64 + fr, col0 = pn * BM + wc * 32 + 8 * fq, ocol = dcol + wc * 32 + 8 * fq;
        const int kind = (pn >= 6 && pn < 8) ? 1 : ((pn >= 8 && pn < 10) || (pn >= 12 && pn < 14)) ? 2 : (pn >= 14 && pn < 18) ? 3 : (pn >= 18) ? 1 : 0;
        f32x4 bv[2][2], lbv[2][2];
#pragma unroll
        for (int bj = 0; bj < 2; ++bj)
#pragma unroll
            for (int n = 0; n < 2; ++n) {
                const int cl = (wc * 32 + 8 * fq + bj * HALF + 4 * n) * 4;
                bv[bj][n] = *(const LAS f32x4*)(eb + cl);
                lbv[bj][n] = (f32x4){0.f, 0.f, 0.f, 0.f};
                if (kind == 3) { const f32x4 r0 = *(const LAS f32x4*)(eb + 1024 + cl), r1 = *(const LAS f32x4*)(eb + 2048 + cl);
#pragma unroll
                    for (int j = 0; j < 4; ++j) lbv[bj][n][j] = 1.0f - 1.0f / (1.0f + __expf(r1[j] - r0[j])); }
            }
#pragma unroll
        for (int ai = 0; ai < 2; ++ai)
#pragma unroll
            for (int m = 0; m < 4; ++m) { bf16_t* rowp = base + (size_t)(row0 + ai * HALF + m * 16) * ldw + ocol;
#pragma unroll
                for (int bj = 0; bj < 2; ++bj) { f32x4 v0 = acc[ai][bj][m][0] + bv[bj][0], v1 = acc[ai][bj][m][1] + bv[bj][1];
                    if (kind == 1) {
#pragma unroll
                        for (int j = 0; j < 4; ++j) { v0[j] = sigmoidf_(v0[j]); v1[j] = sigmoidf_(v1[j]); } }
                    else if (kind == 2) {
#pragma unroll
                        for (int j = 0; j < 4; ++j) { v0[j] = siluf_(v0[j]); v1[j] = siluf_(v1[j]); } }
                    else if (kind == 3) {
#pragma unroll
                        for (int j = 0; j < 4; ++j) { v0[j] = lbv[bj][0][j] * __builtin_amdgcn_rcpf(1.0f + __builtin_amdgcn_exp2f(1.4426950408889634f * v0[j])); v1[j] = lbv[bj][1][j] * __builtin_amdgcn_rcpf(1.0f + __builtin_amdgcn_exp2f(1.4426950408889634f * v1[j])); } }
                    u32x4 w; w.x = cvt_pk_bf16(v0[0], v0[1]); w.y = cvt_pk_bf16(v0[2], v0[3]); w.z = cvt_pk_bf16(v1[0], v1[1]); w.w = cvt_pk_bf16(v1[2], v1[3]);
                    *(u32x4*)(rowp + bj * HALF) = w; } }
    }
};
struct EpiY {
    static constexpr bool PERM = true, MID = false, CARRY = true, FP8 = false;
    bf16_t* Y; const bf16_t* P;
    __device__ __forceinline__ void prefetch(const Unit&, LAS unsigned char*, int, int) const {}
    __device__ __forceinline__ bool first_pass(const Unit& u) const { return u.e == 0; }
    __device__ __forceinline__ void rescale(f32x4 (&acc)[2][2][4][2], const Unit& u, int wr, int wc, int fr, int fq) const {
        const int row0 = u.pm * BM + wr * 64 + fr, col0 = u.pn * BM + wc * 32 + 8 * fq;
#pragma unroll
        for (int ai = 0; ai < 2; ++ai)
#pragma unroll
            for (int mh = 0; mh < 2; ++mh) {
                u32x4 ga[2][2], gb[2][2];
#pragma unroll
                for (int m2 = 0; m2 < 2; ++m2) { const size_t r = (size_t)(row0 + ai * HALF + (2 * mh + m2) * 16);
#pragma unroll
                    for (int bj = 0; bj < 2; ++bj) { ga[m2][bj] = *(const u32x4*)(P + r * PL_W + PL_GA + col0 + bj * HALF); gb[m2][bj] = *(const u32x4*)(P + r * PL_W + PL_GB + col0 + bj * HALF); } }
#pragma unroll
                for (int m2 = 0; m2 < 2; ++m2)
#pragma unroll
                    for (int bj = 0; bj < 2; ++bj) { float a[8], b[8]; unpack8(ga[m2][bj], a); unpack8(gb[m2][bj], b);
#pragma unroll
                        for (int j = 0; j < 4; ++j) { acc[ai][bj][2 * mh + m2][0][j] *= a[j] * __builtin_amdgcn_rcpf(b[j]); acc[ai][bj][2 * mh + m2][1][j] *= a[4 + j] * __builtin_amdgcn_rcpf(b[4 + j]); } }
                asm volatile("" ::: "memory");
            }
    }
    __device__ __forceinline__ void operator()(const f32x4 (&acc)[2][2][4][2], const Unit& u, int wr, int wc, int fr, int fq, const LAS unsigned char*) const {
        const int row0 = u.pm * BM + wr * 64 + fr, col0 = u.pn * BM + wc * 32 + 8 * fq;
#pragma unroll
        for (int ai = 0; ai < 2; ++ai) {
            u32x4 gg[4][2];
#pragma unroll
            for (int m = 0; m < 4; ++m) { const size_t r = (size_t)(row0 + ai * HALF + m * 16);
#pragma unroll
                for (int bj = 0; bj < 2; ++bj) gg[m][bj] = *(const u32x4*)(P + r * PL_W + PL_GB + col0 + bj * HALF); }
#pragma unroll
            for (int m = 0; m < 4; ++m) { const size_t r = (size_t)(row0 + ai * HALF + m * 16);
#pragma unroll
                for (int bj = 0; bj < 2; ++bj) { float b[8], o[8]; unpack8(gg[m][bj], b); const f32x4 v0 = acc[ai][bj][m][0], v1 = acc[ai][bj][m][1];
#pragma unroll
                    for (int j = 0; j < 4; ++j) { o[j] = v0[j] * b[j]; o[4 + j] = v1[j] * b[4 + j]; }
                    *(u32x4*)(Y + r * D + col0 + bj * HALF) = pack8(o); } }
            asm volatile("" ::: "memory");
        }
    }
};
struct EpiAct {
    static constexpr bool PERM = true, MID = false, CARRY = false, FP8 = true;
    unsigned char* ACT; const float* b_gu;
    __device__ __forceinline__ void prefetch(const Unit& u, LAS unsigned char* eb, int wid, int lane) const {
        if (wid == 0) __builtin_amdgcn_global_load_lds((const unsigned*)(b_gu + (size_t)u.e * 2048 + (lane >> 5) * 1024 + u.pn * 128 + 4 * (lane & 31)), (LAS unsigned*)eb, 16, 0, 0);
    }
    __device__ __forceinline__ void operator()(const f32x4 (&acc)[2][2][4][2], const Unit& u, int wr, int wc, int fr, int fq, const LAS unsigned char* eb) const {
        const int row0 = u.pm * BM + wr * 64 + fr, col0 = u.pn * HALF + wc * 32 + 8 * fq;
        const LAS unsigned char* bg = eb + (wc * 32 + 8 * fq) * 4;
        const f32x4 bg0 = *(const LAS f32x4*)(bg), bg1 = *(const LAS f32x4*)(bg + 16), bu0 = *(const LAS f32x4*)(bg + 512), bu1 = *(const LAS f32x4*)(bg + 528);
#pragma unroll
        for (int ai = 0; ai < 2; ++ai)
#pragma unroll
            for (int m = 0; m < 4; ++m) {
                const f32x4 g0 = acc[ai][0][m][0] * (1.0f / F8_WSCALE) + bg0, g1 = acc[ai][0][m][1] * (1.0f / F8_WSCALE) + bg1, u0 = acc[ai][1][m][0] * (1.0f / F8_WSCALE) + bu0, u1 = acc[ai][1][m][1] * (1.0f / F8_WSCALE) + bu1;
                float o[8];
#pragma unroll
                for (int j = 0; j < 4; ++j) {
                    { const float g = fminf(g0[j], 7.0f), up = fminf(fmaxf(u0[j], -7.0f), 7.0f); o[j] = (F8_ASCALE * (up + 1.0f)) * g * __builtin_amdgcn_rcpf(1.0f + __builtin_amdgcn_exp2f(-2.4554669595930156f * g)); }
                    { const float g = fminf(g1[j], 7.0f), up = fminf(fmaxf(u1[j], -7.0f), 7.0f); o[4 + j] = (F8_ASCALE * (up + 1.0f)) * g * __builtin_amdgcn_rcpf(1.0f + __builtin_amdgcn_exp2f(-2.4554669595930156f * g)); } }
                u32x2 w; w.x = pk_fp8x4(o[0], o[1], o[2], o[3]); w.y = pk_fp8x4(o[4], o[5], o[6], o[7]);
                *(u32x2*)(ACT + (size_t)(row0 + ai * HALF + m * 16) * D + col0) = w; }
    }
};
struct EpiDown {
    static constexpr bool PERM = true, MID = false, CARRY = false, FP8 = true;
    unsigned char* YB; const float* b_dn; const float* pw;
    __device__ __forceinline__ void prefetch(const Unit& u, LAS unsigned char* eb, int wid, int lane) const {
        if (wid == 0) __builtin_amdgcn_global_load_lds((const unsigned*)(b_dn + (size_t)u.e * D + u.pn * 256 + 4 * lane), (LAS unsigned*)eb, 16, 0, 0);
        if (wid == 1) __builtin_amdgcn_global_load_lds((const unsigned*)(pw + (size_t)u.pm * 256 + 4 * lane), (LAS unsigned*)(eb + 1024), 16, 0, 0);
    }
    __device__ __forceinline__ void operator()(const f32x4 (&acc)[2][2][4][2], const Unit& u, int wr, int wc, int fr, int fq, const LAS unsigned char* eb) const {
        const int row0 = u.pm * BM + wr * 64 + fr, col0 = u.pn * BM + wc * 32 + 8 * fq;
        f32x4 bv[2][2];
#pragma unroll
        for (int bj = 0; bj < 2; ++bj)
#pragma unroll
            for (int n = 0; n < 2; ++n) bv[bj][n] = *(const LAS f32x4*)(eb + (wc * 32 + 8 * fq + bj * HALF + 4 * n) * 4);
#pragma unroll
        for (int ai = 0; ai < 2; ++ai)
#pragma unroll
            for (int m = 0; m < 4; ++m) { const size_t r = (size_t)(row0 + ai * HALF + m * 16); const float w = F8_YSCALE * *(const LAS float*)(eb + 1024 + (wr * 64 + fr + ai * HALF + m * 16) * 4);
#pragma unroll
                for (int bj = 0; bj < 2; ++bj) { const f32x4 v0 = (acc[ai][bj][m][0] * (1.0f / (F8_WSCALE * F8_ASCALE)) + bv[bj][0]) * w, v1 = (acc[ai][bj][m][1] * (1.0f / (F8_WSCALE * F8_ASCALE)) + bv[bj][1]) * w;
                    u32x2 o; o.x = pk_fp8x4(v0[0], v0[1], v0[2], v0[3]); o.y = pk_fp8x4(v1[0], v1[1], v1[2], v1[3]);
                    *(u32x2*)(YB + r * D + col0 + bj * HALF) = o; } }
    }
};
}

struct WItem { const float* src; bf16_t* dst; int ld, ldd; };
__device__ __forceinline__ void witem_load(const WItem& w, f32x4 (&v)[16], int lane) {
#pragma unroll
    for (int i = 0; i < 16; ++i) v[i] = __builtin_nontemporal_load((const f32x4*)(w.src + (size_t)(8 * i + (lane >> 3)) * w.ld + (lane & 7) * 4));
}
template <bool F8>
__device__ __forceinline__ void witem_finish(const WItem& w, const f32x4 (&v)[16], LAS float* scr, int lane) {
#pragma unroll
    for (int i = 0; i < 16; ++i) { LAS float* d = scr + (8 * i + (lane >> 3)) * 33 + (lane & 7) * 4; d[0] = v[i][0]; d[1] = v[i][1]; d[2] = v[i][2]; d[3] = v[i][3]; }
    asm volatile("s_waitcnt lgkmcnt(0)" ::: "memory");
    const int c = lane & 15;
#pragma unroll
    for (int j = 0; j < 8; ++j) { const int n = (lane >> 4) + 4 * j; const LAS float* s = scr + (8 * c) * 33 + n;
        if constexpr (F8) { u32x2 o; o.x = pk_fp8x4(F8_WSCALE * s[0 * 33], F8_WSCALE * s[1 * 33], F8_WSCALE * s[2 * 33], F8_WSCALE * s[3 * 33]); o.y = pk_fp8x4(F8_WSCALE * s[4 * 33], F8_WSCALE * s[5 * 33], F8_WSCALE * s[6 * 33], F8_WSCALE * s[7 * 33]);
            *(u32x2*)((unsigned char*)w.dst + (size_t)n * w.ldd + 8 * c) = o; }
        else { u32x4 o; o.x = cvt_pk_bf16(s[0 * 33], s[1 * 33]); o.y = cvt_pk_bf16(s[2 * 33], s[3 * 33]); o.z = cvt_pk_bf16(s[4 * 33], s[5 * 33]); o.w = cvt_pk_bf16(s[6 * 33], s[7 * 33]);
            *(u32x4*)(w.dst + (size_t)n * w.ldd + 8 * c) = o; } }
    asm volatile("s_waitcnt lgkmcnt(0)" ::: "memory");
}
__device__ __forceinline__ WItem witem_setup(const Params& p, int r) {
    constexpr int I_IN = 8 * 208, I_PA = 4 * 32;
    WItem w;
    if (r < I_IN) { const int kb = r / 208, nb = r % 208; w.src = p.in[10] + (size_t)(128 * kb) * NIN + 32 * nb; w.ld = NIN; w.dst = (bf16_t*)(p.ws + WS_WIN) + (size_t)(32 * nb) * D + 128 * kb; w.ldd = D; return w; } r -= I_IN;
    if (r < I_PA) { const int kb = r / 32, nb = r % 32; w.src = p.in[16] + (size_t)(128 * kb) * D + 32 * nb; w.ld = D; w.dst = (bf16_t*)(p.ws + WS_WPAB) + (size_t)(32 * nb) * 512 + 128 * kb; w.ldd = 512; return w; } r -= I_PA;
    if (r < I_PA) { const int kb = r / 32, nb = r % 32; w.src = p.in[17] + (size_t)(128 * kb) * D + 32 * nb; w.ld = D; w.dst = (bf16_t*)(p.ws + WS_WPAB) + (size_t)D * 512 + (size_t)(32 * nb) * 512 + 128 * kb; w.ldd = 512; return w; } r -= I_PA;
    { const int kb = r / 32, nb = r % 32; w.src = p.in[18] + (size_t)(128 * kb) * D + 32 * nb; w.ld = D; w.dst = (bf16_t*)(p.ws + WS_WOUT) + (size_t)(32 * nb) * D + 128 * kb; w.ldd = D; return w; }
}
__device__ __forceinline__ WItem witem_exp(const Params& p, int r) {
    constexpr int I_GU = NE * 8 * 64;
    WItem w; w.ldd = D;
    if (r < I_GU) { const int e = r / 512, q = r % 512, kb = q / 64, nb = q % 64, n0 = 32 * nb, jj = n0 & 1023, half = n0 >> 10, row0 = (jj >> 7) * 256 + half * 128 + (jj & 127);
        w.src = p.in[21] + (size_t)e * D * 2048 + (size_t)(128 * kb) * 2048 + n0; w.ld = 2048; w.dst = (bf16_t*)(p.ws + WS_WGU + ((size_t)e * 2048 + row0) * D + 128 * kb); return w; } r -= I_GU;
    { const int e = r / 256, q = r % 256, kb = q / 32, nb = q % 32;
        w.src = p.in[23] + (size_t)e * D * D + (size_t)(128 * kb) * D + 32 * nb; w.ld = D; w.dst = (bf16_t*)(p.ws + WS_WDN + ((size_t)e * D + 32 * nb) * D + 128 * kb); return w; }
}
template <bool EXP>
__device__ __forceinline__ void wconvert(const Params& p, LAS unsigned char* lds, int nitems) {
    const int tid = otid(), lane = tid & 63, wave = __builtin_amdgcn_readfirstlane(tid >> 6);
    LAS float* scr = (LAS float*)(lds + wave * 16896);
    const int gw = blockIdx.x * 8 + wave, NGW = gridDim.x * 8;
    f32x4 va[16], vb[16]; WItem wa, wb;
    int it = gw;
    if (it < nitems) { wa = EXP ? witem_exp(p, it) : witem_setup(p, it); witem_load(wa, va, lane); }
#pragma unroll 1
    for (; it < nitems; it += 2 * NGW) {
        const bool hb = it + NGW < nitems;
        if (hb) { wb = EXP ? witem_exp(p, it + NGW) : witem_setup(p, it + NGW); witem_load(wb, vb, lane); }
        witem_finish<EXP>(wa, va, scr, lane);
        if (it + 2 * NGW < nitems) { wa = EXP ? witem_exp(p, it + 2 * NGW) : witem_setup(p, it + 2 * NGW); witem_load(wa, va, lane); }
        if (hb) witem_finish<EXP>(wb, vb, scr, lane);
    }
}
__device__ __forceinline__ void ph_setup(const Params& p, LAS unsigned char* lds) {
    const int tid = otid();
    {
        LAS float* sT = (LAS float*)lds;
        LAS float* red = (LAS float*)(lds + 81920);
        const float* c = p.in[1]; const float* cctx = p.in[3]; const float* w_ada = p.in[4]; const float* b_ada = p.in[5];
        float* mod = (float*)(p.ws + WS_MOD);
        bool did = false;
        for (int item = blockIdx.x; item < 192; item += gridDim.x) {
            if (!did) { for (int idx = tid; idx < 17 * 1024; idx += 512) { const int r = idx >> 10, k = idx & 1023; const float v = r < 16 ? c[r * 1024 + k] : cctx[k]; sT[k * 20 + r] = siluf_(v); } __syncthreads(); did = true; }
            const int col = tid & 31, ks = tid >> 5, j = item * 32 + col;
            float acc[17];
#pragma unroll
            for (int r = 0; r < 17; ++r) acc[r] = 0.f;
            for (int kk = 0; kk < 64; ++kk) { const int k = ks * 64 + kk; const float w = w_ada[(size_t)k * 6144 + j];
#pragma unroll
                for (int r = 0; r < 17; ++r) acc[r] += sT[k * 20 + r] * w; }
#pragma unroll
            for (int r = 0; r < 17; ++r) red[(ks * 17 + r) * 32 + col] = acc[r];
            __syncthreads();
            for (int o = tid; o < 17 * 32; o += 512) { const int r = o >> 5, cc = o & 31; float s = b_ada[item * 32 + cc];
                for (int k2 = 0; k2 < 16; ++k2) s += red[(k2 * 17 + r) * 32 + cc];
                mod[r * 6144 + item * 32 + cc] = s; }
            __syncthreads();
        }
        __syncthreads();
    }
    wconvert<false>(p, lds, 8 * 208 + 2 * 4 * 32 + 8 * 32);
}
__device__ __forceinline__ void ph_wexp(const Params& p, LAS unsigned char* lds) { wconvert<true>(p, lds, NE * 8 * 64 + NE * 8 * 32); }

__device__ __forceinline__ void ph_hl(const Params& p, LAS unsigned char* lds) {
    const int tid = otid(), lane = tid & 63, wave = __builtin_amdgcn_readfirstlane(tid >> 6);
    constexpr int TP = 1025;
    LAS float* tile = (LAS float*)lds;
    const float* w_in = p.in[10];
    const int rt = wave & 1, ksl = wave >> 1;
    float breg[64];
#pragma unroll
    for (int s = 0; s < 64; ++s) breg[s] = w_in[(size_t)(256 * ksl + 4 * s + (lane >> 4)) * NIN + C_MG + (lane & 15)];
    const float* x = p.in[0]; const float* ctx = p.in[2]; const float* wpre = p.in[6]; const float* b_in = p.in[11];
    const float* mod = (const float*)(p.ws + WS_MOD); float* mg = (float*)(p.ws + WS_MG); bf16_t* HL = (bf16_t*)(p.ws + WS_HL);
    f32x4 vg[4][4];
#define HL_LOADG(r0_) do { _Pragma("unroll") for (int tt_ = 0; tt_ < 4; ++tt_) { const int r_ = (r0_) + wave * 4 + tt_; const float* src_ = r_ < NTOK ? x + (size_t)r_ * D : ctx + (size_t)(r_ - NTOK) * D; \
        _Pragma("unroll") for (int j_ = 0; j_ < 4; ++j_) vg[tt_][j_] = __builtin_nontemporal_load((const f32x4*)src_ + lane + 64 * j_); } } while (0)
    if ((int)blockIdx.x < MROWS / 32) HL_LOADG(blockIdx.x * 32);
    for (int grp = blockIdx.x; grp < MROWS / 32; grp += gridDim.x) {
        const int r0 = grp * 32;
        const int b = r0 < NTOK ? (r0 >> 11) : 16;
        const float* sh = mod + b * 6144; const float* sc = sh + 1024;
#pragma unroll
        for (int tt = 0; tt < 4; ++tt) {
            const int rl = wave * 4 + tt, r = r0 + rl;
            f32x4 v[4]; float ss = 0.f;
#pragma unroll
            for (int j = 0; j < 4; ++j) { v[j] = vg[tt][j]; ss += v[j].x * v[j].x + v[j].y * v[j].y + v[j].z * v[j].z + v[j].w * v[j].w; }
            ss = wave_sum(ss); const float rstd = rsqrtf(ss * (1.0f / D) + EPS);
#pragma unroll
            for (int j = 0; j < 4; ++j) { const int ci = 4 * lane + 256 * j;
                const f32x4 wv = *(const f32x4*)(wpre + ci), shv = *(const f32x4*)(sh + ci), scv = *(const f32x4*)(sc + ci);
                LAS float* trow = tile + rl * TP + ci;
                f32x4 h;
#pragma unroll
                for (int i = 0; i < 4; ++i) { h[i] = v[j][i] * rstd * wv[i] * (1.0f + scv[i]) + shv[i]; trow[i] = h[i]; }
                u32x2 o; o.x = cvt_pk_bf16(h[0], h[1]); o.y = cvt_pk_bf16(h[2], h[3]);
                *(u32x2*)(HL + (size_t)r * D + ci) = o; }
        }
        __syncthreads();
        if (grp + (int)gridDim.x < MROWS / 32) HL_LOADG((grp + (int)gridDim.x) * 32);
        f32x4 acc = (f32x4){0.f, 0.f, 0.f, 0.f};
        { const LAS float* ap = tile + (16 * rt + (lane & 15)) * TP + 256 * ksl + (lane >> 4);
#pragma unroll
            for (int s = 0; s < 64; ++s) acc = __builtin_amdgcn_mfma_f32_16x16x4f32(ap[4 * s], breg[s], acc, 0, 0, 0); }
        __syncthreads();
#pragma unroll
        for (int r = 0; r < 4; ++r) tile[(ksl * 32 + 16 * rt + 4 * (lane >> 4) + r) * 16 + (lane & 15)] = acc[r];
        __syncthreads();
        { const int row = tid >> 4, col = tid & 15; mg[(size_t)(r0 + row) * 16 + col] = b_in[C_MG + col] + (tile[row * 16 + col] + tile[(32 + row) * 16 + col]) + (tile[(64 + row) * 16 + col] + tile[(96 + row) * 16 + col]); }
        __syncthreads();
    }
}

__device__ __forceinline__ float logsigf_(float x) { return fminf(x, 0.f) - __logf(1.0f + __expf(-fabsf(x))); }
__device__ __forceinline__ bf16_t tobf(float f) { return (bf16_t)(cvt_pk_bf16(f, 0.f) & 0xffffu); }
__device__ __forceinline__ float ldsbf(const LAS unsigned char* p) { return __uint_as_float(((unsigned)*(const LAS bf16_t*)p) << 16); }
constexpr int PR_HALO = 256, PR_T = 49408, PR_W = 131328, PR_SEG = 131840, PR_SEGSZ = 8192;
static_assert(PR_SEG + PR_SEGSZ <= LDS_BYTES - 16, "prep LDS map");
__device__ __forceinline__ void pr_dma_tile(LAS unsigned char* lds, int ldsoff, const char* gsrc, size_t pitchB, int w, int lane) {
#pragma unroll
    for (int i = 0; i < 2; ++i) { const int r0 = 8 * w + 4 * i;
        __builtin_amdgcn_global_load_lds((const unsigned*)(gsrc + (size_t)(r0 + (lane >> 4)) * pitchB + (lane & 15) * 16), (LAS unsigned*)(lds + ldsoff + r0 * 256), 16, 0, 0); }
}
__device__ __forceinline__ void pr_flush_nat(const LAS unsigned char* lds, int ldsoff, char* gdst, size_t pitchB, int tid) {
#pragma unroll
    for (int ps = 0; ps < 2; ++ps) { const int row = (tid >> 4) + 32 * ps, u = tid & 15; *(u32x4*)(gdst + (size_t)row * pitchB + u * 16) = *(const LAS u32x4*)(lds + ldsoff + row * 256 + u * 16); }
}
__device__ __forceinline__ void pr_flush_tr(const LAS unsigned char* lds, int ldsoff, char* gdst, int tid) {
#pragma unroll
    for (int ps = 0; ps < 2; ++ps) { const int idx = tid + 512 * ps, c = idx >> 3, u = idx & 7; *(u32x4*)(gdst + (size_t)idx * 16) = *(const LAS u32x4*)(lds + ldsoff + c * 128 + ((u ^ (c & 7)) << 4)); }
}
__device__ __forceinline__ f32x2 ldsbf2(const LAS unsigned char* p) { const unsigned w = *(const LAS unsigned*)p; return (f32x2){bf_lo(w), bf_hi(w)}; }
__device__ __forceinline__ f32x2 exp2v(f32x2 x) { return (f32x2){__expf(x.x), __expf(x.y)}; }
__device__ __forceinline__ f32x2 log1mv(f32x2 k) { return (f32x2){__logf(1.0f - k.x), __logf(1.0f - k.y)}; }
__device__ __forceinline__ void pr_tstore8(LAS unsigned char* lds, int ldsoff, int cp, int seg, const f32x2 (&f)[8]) {
    u32x4 a, b;
    a.x = cvt_pk_bf16(f[0].x, f[1].x); a.y = cvt_pk_bf16(f[2].x, f[3].x); a.z = cvt_pk_bf16(f[4].x, f[5].x); a.w = cvt_pk_bf16(f[6].x, f[7].x);
    b.x = cvt_pk_bf16(f[0].y, f[1].y); b.y = cvt_pk_bf16(f[2].y, f[3].y); b.z = cvt_pk_bf16(f[4].y, f[5].y); b.w = cvt_pk_bf16(f[6].y, f[7].y);
    const int c0 = 2 * cp, c1 = 2 * cp + 1;
    *(LAS u32x4*)(lds + ldsoff + c0 * 128 + ((seg ^ (c0 & 7)) << 4)) = a;
    *(LAS u32x4*)(lds + ldsoff + c1 * 128 + ((seg ^ (c1 & 7)) << 4)) = b;
}
__device__ __forceinline__ void pr_conv8p(const LAS unsigned char* halo, const f32x2 (&cwv)[9], bool lat, int cc, int s0, int cp, f32x2 (&o)[8]) {
#pragma unroll
    for (int j = 0; j < 8; ++j) o[j] = (f32x2){0.f, 0.f};
    if (lat) {
        const int gi = cc - 4;
#pragma unroll
        for (int di = 0; di < 3; ++di) {
            const int ii = gi + di - 1; const bool rok = ii >= 0 && ii < 32;
            f32x2 x[10];
#pragma unroll
            for (int jj = 0; jj < 10; ++jj) { const int gj = s0 + jj - 1; const f32x2 v = ldsbf2(halo + di * 16384 + gj * 256 + cp * 4); x[jj] = (rok && gj >= 0 && gj < 64) ? v : (f32x2){0.f, 0.f}; }
#pragma unroll
            for (int dj = 0; dj < 3; ++dj) { const f32x2 w = cwv[di * 3 + dj];
#pragma unroll
                for (int j = 0; j < 8; ++j) o[j] += w * x[j + dj]; }
        }
    } else {
        f32x2 x[10];
#pragma unroll
        for (int jj = 0; jj < 10; ++jj) { const int fl = 64 + s0 + jj - 1, tt = cc * 64 + s0 + jj - 1; const f32x2 v = ldsbf2(halo + fl * 256 + cp * 4); x[jj] = (tt >= 0 && tt < TC) ? v : (f32x2){0.f, 0.f}; }
#pragma unroll
        for (int dj = 0; dj < 3; ++dj) { const f32x2 w = cwv[3 + dj];
#pragma unroll
            for (int j = 0; j < 8; ++j) o[j] += w * x[j + dj]; }
    }
}
#define PR_BAR() do { asm volatile("s_waitcnt lgkmcnt(0)" ::: "memory"); __builtin_amdgcn_s_barrier(); asm volatile("" ::: "memory"); } while (0)
__device__ __forceinline__ void ph_prep(const Params& p, LAS unsigned char* lds) {
    const int tid = otid(), lane = tid & 63, wave = __builtin_amdgcn_readfirstlane(tid >> 6);
    const int cp = tid & 63, seg = tid >> 6, s0 = 8 * seg;
    LAS float* wS = (LAS float*)(lds + PR_W);
    LAS float* segS = (LAS float*)(lds + PR_SEG);
    const char* PD = (const char*)(p.ws + WS_PD); char* QK = (char*)(p.ws + WS_QK);
    const float* mg = (const float*)(p.ws + WS_MG); const float* cw = p.in[12];
    float* GW = (float*)(p.ws + WS_GW); float* G1 = (float*)(p.ws + WS_G1); bf16_t* WB = (bf16_t*)(p.ws + WS_WB);
    float* DEC = (float*)(p.ws + WS_DEC); float* EAL = (float*)(p.ws + WS_EAL);
    constexpr int T0 = PR_T, T1 = PR_T + 16384, T2 = PR_T + 32768, T3 = PR_T + 49152, T4 = PR_T + 65536, H0 = PR_HALO, H1 = PR_HALO + 16384, H2 = PR_HALO + 32768;
    constexpr size_t PDP = (size_t)PD_W * 2;
    for (int unit = blockIdx.x; unit < NB * 36 * 4; unit += gridDim.x) {
        const int h = unit & 3, cc = (unit >> 2) % 36, b = unit / 144;
        const bool lat = cc >= 4; const int u0 = cc * 64; const int row0 = lat ? b * T + (cc - 4) * 64 : NTOK + b * TC + cc * 64;
        const int bh = b * 4 + h;
        const size_t trb = ((size_t)bh * 36 + cc) * 16384;
        {
            const int colk = PD_MK + h * 128;
#pragma unroll
            for (int di = 0; di < 3; ++di) { const int rr = lat ? (cc - 4) + di - 1 : cc + di - 1; const bool ok = lat ? (rr >= 0 && rr < 32) : (rr >= 0 && rr < 4);
                if (ok) pr_dma_tile(lds, PR_HALO + di * 16384, PD + (size_t)(lat ? b * T + rr * 64 : NTOK + b * TC + rr * 64) * PDP + colk * 2, PDP, wave, lane); }
            pr_dma_tile(lds, T0, PD + (size_t)row0 * PDP + (PD_MV + h * 128) * 2, PDP, wave, lane);
        }
        f32x2 wk[9], wq[9];
#pragma unroll
        for (int t9 = 0; t9 < 9; ++t9) { wk[t9] = *(const f32x2*)(cw + t9 * 1024 + PD_MK + h * 128 + 2 * cp); wq[t9] = *(const f32x2*)(cw + t9 * 1024 + PD_MQ + h * 128 + 2 * cp); }
        if (wave < 2) {
            const int dir = wave; const int s = dir ? 63 - lane : lane; const float* g = mg + (size_t)(row0 + s) * 16;
            const float ipre = g[dir * 4 + h], fpre = g[(2 + dir) * 4 + h]; float bs = logsigf_(fpre);
#pragma unroll
            for (int o = 1; o < 64; o <<= 1) { const float tt = __shfl_up(bs, o); if (lane >= o) bs += tt; }
            const float bL = __shfl(bs, 63); const float w = __expf(bL - bs + ipre), g1 = __expf(bs - bL);
            const size_t gi = (size_t)(bh * 2 + dir) * 2304 + u0; wS[dir * 64 + s] = w; GW[gi + s] = w; G1[gi + s] = g1;
            WB[gi + s] = tobf(w);
            if (lane == 63) DEC[(bh * 2 + dir) * 36 + cc] = __expf(bL);
        }
        asm volatile("s_waitcnt vmcnt(0)" ::: "memory"); PR_BAR();
        {
            f32x2 o[8];
            pr_conv8p(lds + PR_HALO, wk, lat, cc, s0, cp, o);
#pragma unroll
            for (int j = 0; j < 8; ++j) { o[j].x = siluf_(o[j].x); o[j].y = siluf_(o[j].y); }
            pr_tstore8(lds, T2, cp, seg, o);
            asm volatile("" ::: "memory");
            f32x2 vf[8];
#pragma unroll
            for (int j = 0; j < 8; ++j) { o[j] = ldsbf2(lds + T0 + (s0 + j) * 256 + cp * 4); vf[j] = o[j] * wS[s0 + j]; }
            pr_tstore8(lds, T3, cp, seg, vf);
            asm volatile("" ::: "memory");
#pragma unroll
            for (int j = 0; j < 8; ++j) vf[j] = o[j] * wS[64 + s0 + j];
            pr_tstore8(lds, T4, cp, seg, vf);
        }
        PR_BAR();
        if (lat) {
#pragma unroll
            for (int di = 0; di < 3; ++di) { const int rr = (cc - 4) + di - 1; if (rr >= 0 && rr < 32) pr_dma_tile(lds, PR_HALO + di * 16384, PD + (size_t)(b * T + rr * 64) * PDP + (PD_MQ + h * 128) * 2, PDP, wave, lane); }
        }
        pr_dma_tile(lds, T0, PD + (size_t)row0 * PDP + (PD_HF + h * 128) * 2, PDP, wave, lane);
        pr_flush_tr(lds, T2, (char*)(p.ws + WS_KT) + trb, tid); pr_flush_tr(lds, T3, (char*)(p.ws + WS_VTF) + trb, tid); pr_flush_tr(lds, T4, (char*)(p.ws + WS_VTB) + trb, tid);
        PR_BAR();
        pr_dma_tile(lds, T2, PD + (size_t)row0 * PDP + (PD_HF + 512 + h * 128) * 2, PDP, wave, lane);
        if (lat) pr_dma_tile(lds, T3, PD + (size_t)row0 * PDP + (PD_HQ + h * 128) * 2, PDP, wave, lane);
        pr_dma_tile(lds, T4, PD + (size_t)row0 * PDP + (PD_HI + h * 128) * 2, PDP, wave, lane);
        if (lat) {
            asm volatile("s_waitcnt vmcnt(6)" ::: "memory"); PR_BAR();
            f32x2 o[8];
            pr_conv8p(lds + PR_HALO, wq, true, cc, s0, cp, o);
#pragma unroll
            for (int j = 0; j < 8; ++j) *(LAS unsigned*)(lds + T1 + (s0 + j) * 256 + cp * 4) = cvt_pk_bf16(siluf_(o[j].x) * 0.08838834764831845f, siluf_(o[j].y) * 0.08838834764831845f);
            PR_BAR();
            pr_flush_nat(lds, T1, QK + (size_t)row0 * (D * 2) + (h * 128) * 2, (size_t)D * 2, tid);
        }
        asm volatile("s_waitcnt vmcnt(0)" ::: "memory"); PR_BAR();
        {
            const int ob = s0 * 256 + cp * 4;
            f32x2 locf = (f32x2){0.f, 0.f}, locb = locf;
            { f32x2 iv[8];
#pragma unroll
                for (int j = 0; j < 8; ++j) { iv[j] = ldsbf2(lds + T4 + ob + j * 256); locf += log1mv(ldsbf2(lds + T0 + ob + j * 256)); locb += log1mv(ldsbf2(lds + T2 + ob + j * 256)); }
                pr_tstore8(lds, H0, cp, seg, iv); }
            *(LAS f32x2*)(segS + seg * 128 + 2 * cp) = locf; *(LAS f32x2*)(segS + (8 + seg) * 128 + 2 * cp) = locb;
            PR_BAR();
            f32x2 pf = (f32x2){0.f, 0.f}, tf = pf, pb = pf, tbk = pf;
#pragma unroll
            for (int sg = 0; sg < 8; ++sg) { const f32x2 a = *(const LAS f32x2*)(segS + sg * 128 + 2 * cp), bq = *(const LAS f32x2*)(segS + (8 + sg) * 128 + 2 * cp); tf += a; tbk += bq; if (sg < seg) { pf += a; pb += bq; } }
            f32x2 ke[8];
            {
                f32x2 run = pf;
#pragma unroll
                for (int j = 0; j < 8; ++j) { const f32x2 kk = ldsbf2(lds + T0 + ob + j * 256), qv = ldsbf2(lds + T3 + ob + j * 256); run += log1mv(kk);
                    f32x2 x = tf - run; x.x = fmaxf(x.x, -80.f); x.y = fmaxf(x.y, -80.f);
                    ke[j] = kk * exp2v(x); const f32x2 qp = qv * exp2v(-x);
                    *(LAS unsigned*)(lds + T1 + ob + j * 256) = lat ? cvt_pk_bf16(qp.x, qp.y) : 0u; }
                pr_tstore8(lds, H1, cp, seg, ke);
            }
            asm volatile("" ::: "memory");
            {
                f32x2 E = pb;
#pragma unroll
                for (int j = 0; j < 8; ++j) { const f32x2 kk = ldsbf2(lds + T2 + ob + j * 256), qv = ldsbf2(lds + T3 + ob + j * 256);
                    f32x2 x = E; x.x = fmaxf(x.x, -80.f); x.y = fmaxf(x.y, -80.f); E += log1mv(kk);
                    ke[j] = kk * exp2v(x); const f32x2 qp = qv * exp2v(-x);
                    *(LAS unsigned*)(lds + T3 + ob + j * 256) = lat ? cvt_pk_bf16(qp.x, qp.y) : 0u; }
                pr_tstore8(lds, H2, cp, seg, ke);
            }
            if (seg == 0) { *(f32x2*)(EAL + ((size_t)(bh * 2 + 0) * 36 + cc) * 128 + 2 * cp) = exp2v(tf); *(f32x2*)(EAL + ((size_t)(bh * 2 + 1) * 36 + cc) * 128 + 2 * cp) = exp2v(tbk); }
        }
        PR_BAR();
        pr_flush_tr(lds, H0, (char*)(p.ws + WS_IT) + trb, tid); pr_flush_tr(lds, H1, (char*)(p.ws + WS_KEFT) + trb, tid); pr_flush_tr(lds, H2, (char*)(p.ws + WS_KEBT) + trb, tid);
        if (lat) { const size_t no = (size_t)row0 * 1024 + (h * 128) * 2;
            pr_flush_nat(lds, T1, (char*)(p.ws + WS_QPFN) + no, 1024, tid); pr_flush_nat(lds, T3, (char*)(p.ws + WS_QPBN) + no, 1024, tid); }
        PR_BAR();
    }
}

#undef PR_BAR
#define MFMA16(a, b, c) __builtin_amdgcn_mfma_f32_16x16x32_bf16((a), (b), (c), 0, 0, 0)
constexpr int SC_ST = 0, SC_BUF = 32768, SC_BUFSZ = 32768, SC_KT = 0, SC_VT = 16384;
constexpr int SC_VEC = SC_BUF + 3 * SC_BUFSZ, SC_VECSZ = 1536, SC_GW = 0, SC_G1 = 256, SC_WB = 512, SC_EAL = 1024, SC_NS = SC_VEC + 3 * SC_VECSZ, SC_DUMMY = SC_NS + 512;
static_assert(SC_DUMMY + 256 <= LDS_BYTES - 16, "scan LDS map");
typedef unsigned short u16x4 __attribute__((ext_vector_type(4)));
template <bool MLSTM>
__device__ __forceinline__ void scan2_item(const Params& p, LAS unsigned char* lds, int b, int h, int dir) {
    const int tid = otid(), lane = tid & 63, w = __builtin_amdgcn_readfirstlane(tid >> 6), j15 = lane & 15, kq = lane >> 4;
    const int dh = w >> 2, vq = w & 3, rb = w & 3, vh = w >> 2;
    const int bh = b * 4 + h, bhd = bh * 2 + dir;
    const int npitch = MLSTM ? D : 512;
    const bf16_t* QNarr = MLSTM ? (const bf16_t*)(p.ws + WS_QK) + h * 128 : (const bf16_t*)(p.ws + (dir ? WS_QPBN : WS_QPFN)) + h * 128;
    const bf16_t* KTarr = (const bf16_t*)(p.ws + (MLSTM ? WS_KT : (dir ? WS_KEBT : WS_KEFT))) + (size_t)bh * 36 * 8192;
    const bf16_t* VTarr = (const bf16_t*)(p.ws + (MLSTM ? (dir ? WS_VTB : WS_VTF) : WS_IT)) + (size_t)bh * 36 * 8192;
    const float* GWarr = (const float*)(p.ws + WS_GW) + (size_t)bhd * 2304; const float* G1arr = (const float*)(p.ws + WS_G1) + (size_t)bhd * 2304;
    const bf16_t* WBarr = (const bf16_t*)(p.ws + WS_WB) + (size_t)bhd * 2304; const float* EALarr = (const float*)(p.ws + WS_EAL) + (size_t)bhd * 36 * 128;
    const float* DEC = (const float*)(p.ws + WS_DEC) + bhd * 36;
    bf16_t* HSo = (bf16_t*)(p.ws + WS_HS) + (size_t)((MLSTM ? 0 : 2) + dir) * NTOK * 512 + h * 128;
    unsigned doff[4];
#pragma unroll
    for (int i = 0; i < 4; ++i) { const int idx = (w * 4 + i) & 15; doff[i] = (unsigned)(((16 * (idx >> 1) + j15) * 64 + 32 * (idx & 1) + 8 * kq) * 2); }
    const unsigned trL = (unsigned)((kq >> 1) * 2048 + (kq & 1) * 128 + ((lane & 15) >> 2) * 16 + ((lane & 3) >> 1) * 256 + (lane & 1) * 8);
    const unsigned vtL = (unsigned)(j15 * 16 + (kq >> 1) * 256 + (kq & 1) * 8);
#define SC_CC(st) (dir == 0 ? (st) : ((st) < 4 ? 3 - (st) : 39 - (st)))
#define SC_ROW0(cc) ((cc) >= 4 ? b * T + ((cc) - 4) * 64 : NTOK + b * TC + (cc) * 64)
#define SC_DMA(st, bufi) do { const int cc_ = SC_CC(st); const unsigned bo_ = SC_BUF + (bufi) * SC_BUFSZ; \
        const char* kt_ = (const char*)(KTarr + (size_t)cc_ * 8192); const char* vt_ = (const char*)(VTarr + (size_t)cc_ * 8192); \
        _Pragma("unroll") for (int i = 0; i < 4; ++i) { const int f = w * 4 + i; const char* g_ = (f < 16 ? kt_ : vt_) + doff[i]; \
            __builtin_amdgcn_global_load_lds((const unsigned*)g_, (LAS unsigned*)(lds + bo_ + f * 1024), 16, 0, 0); } \
        const unsigned vo_ = SC_VEC + (bufi) * SC_VECSZ; const unsigned* vs_ = (const unsigned*)DEC; unsigned vd_ = SC_DUMMY; int lm_ = 0; \
        if (MLSTM) { if (w == 0) { vs_ = (const unsigned*)(GWarr + cc_ * 64); vd_ = vo_ + SC_GW; lm_ = 1; } if (w == 1) { vs_ = (const unsigned*)(G1arr + cc_ * 64); vd_ = vo_ + SC_G1; lm_ = 1; } \
            if (w == 2) { vs_ = (const unsigned*)(WBarr + cc_ * 64); vd_ = vo_ + SC_WB; lm_ = 1; } if (w == 3) { vs_ = (const unsigned*)(DEC + cc_); vd_ = vo_ + SC_EAL; } } \
        else { if (w == 3 || w == 4) { vs_ = (const unsigned*)(EALarr + cc_ * 128 + (w - 3) * 64); vd_ = vo_ + SC_EAL + (w - 3) * 256; lm_ = 1; } } \
        __builtin_amdgcn_global_load_lds(vs_ + lm_ * lane, (LAS unsigned*)(lds + vd_), 4, 0, 0); } while (0)
#define SC_LOADQ(Q, st) do { const int cc_ = SC_CC(st); const bf16_t* qp_ = QNarr + (size_t)(SC_ROW0(cc_) + 16 * rb + j15) * npitch + 8 * kq; \
        asm volatile("global_load_dwordx4 %0, %4, off\n\tglobal_load_dwordx4 %1, %4, off offset:64\n\tglobal_load_dwordx4 %2, %4, off offset:128\n\tglobal_load_dwordx4 %3, %4, off offset:192" \
            : "=&v"(Q[0]), "=&v"(Q[1]), "=&v"(Q[2]), "=&v"(Q[3]) : "v"(qp_) : "memory"); } while (0)
    f32x4 acc[4][2], accn = (f32x4){0.f, 0.f, 0.f, 0.f};
#pragma unroll
    for (int dt = 0; dt < 4; ++dt)
#pragma unroll
        for (int vt = 0; vt < 2; ++vt) acc[dt][vt] = (f32x4){0.f, 0.f, 0.f, 0.f};
    bf16x8 Qa[4], Qb[4];
#pragma unroll
    for (int ks = 0; ks < 4; ++ks) { Qa[ks] = (bf16x8){0, 0, 0, 0, 0, 0, 0, 0}; Qb[ks] = Qa[ks]; }
    __syncthreads();
    if (SC_CC(0) >= 4) SC_LOADQ(Qa, 0);
    SC_DMA(0, 0); SC_DMA(1, 1);
#define SC_WAITFOR(s_) do { if ((s_) == 0) asm volatile("s_waitcnt vmcnt(5)" ::: "memory"); \
        else if ((s_) + 1 < 36) { if (SC_CC((s_) - 1) >= 4) asm volatile("s_waitcnt vmcnt(9)" ::: "memory"); else asm volatile("s_waitcnt vmcnt(5)" ::: "memory"); } \
        else asm volatile("s_waitcnt vmcnt(0)" ::: "memory"); } while (0)
    SC_WAITFOR(0);
#define SC_STEP(Q, QN, st) do { const int cc = SC_CC(st); const bool lat = cc >= 4; const int bi = (st) % 3; \
        const LAS unsigned char* B_ = lds + SC_BUF + bi * SC_BUFSZ; const LAS unsigned char* V_ = lds + SC_VEC + bi * SC_VECSZ; \
        __builtin_amdgcn_s_barrier(); asm volatile("" ::: "memory"); \
        _Pragma("unroll") for (int ks = 0; ks < 4; ++ks) asm volatile("" : "+v"(Q[ks])); \
        if ((st) + 1 < 36 && SC_CC((st) + 1) >= 4) SC_LOADQ(QN, (st) + 1); \
        if ((st) + 2 < 36) { SC_DMA((st) + 2, ((st) + 2) % 3); } \
          \
        if (MLSTM) { const float dec = *(const LAS float*)(V_ + SC_EAL); _Pragma("unroll") for (int dt = 0; dt < 4; ++dt) _Pragma("unroll") for (int vt = 0; vt < 2; ++vt) acc[dt][vt] *= dec; accn *= dec; } \
        else { _Pragma("unroll") for (int dt = 0; dt < 4; ++dt) { const f32x4 e = *(const LAS f32x4*)(V_ + SC_EAL + (64 * dh + 16 * dt + 4 * kq) * 4); _Pragma("unroll") for (int vt = 0; vt < 2; ++vt) acc[dt][vt] *= e; } } \
        if (lat) { _Pragma("unroll") for (int dt = 0; dt < 4; ++dt) _Pragma("unroll") for (int vt = 0; vt < 2; ++vt) { u32x2 v_; v_.x = cvt_pk_bf16(acc[dt][vt][0], acc[dt][vt][1]); v_.y = cvt_pk_bf16(acc[dt][vt][2], acc[dt][vt][3]); \
                *(LAS u32x2*)(lds + SC_ST + (32 * vq + 16 * vt + j15) * 256 + (((8 * dh + 2 * dt + (kq >> 1)) ^ j15) << 4) + 8 * (kq & 1)) = v_; } \
            if (MLSTM && j15 == 0) *(LAS f32x4*)(lds + SC_NS + (16 * (4 * dh + vq) + 4 * kq) * 4) = accn; } \
        asm volatile("s_waitcnt lgkmcnt(0)" ::: "memory"); __builtin_amdgcn_s_barrier(); asm volatile("" ::: "memory"); \
        if (lat) { const int t = 16 * rb + j15; f32x4 Gt[4]; const unsigned tra_ = (unsigned)(size_t)(B_ + SC_KT) + trL; \
            _Pragma("unroll") for (int s4 = 0; s4 < 4; ++s4) { Gt[s4] = (f32x4){0.f, 0.f, 0.f, 0.f}; u16x4 k0_[4], k1_[4]; \
                _Pragma("unroll") for (int ks = 0; ks < 4; ++ks) { const unsigned a_ = tra_ + ks * 4096 + (s4 >> 1) * 1024 + (s4 & 1) * 512; \
                    asm volatile("ds_read_b64_tr_b16 %0, %2\n\tds_read_b64_tr_b16 %1, %2 offset:64" : "=&v"(k0_[ks]), "=&v"(k1_[ks]) : "v"(a_) : "memory"); } \
                asm volatile("s_waitcnt lgkmcnt(0)" ::: "memory"); __builtin_amdgcn_sched_barrier(0); \
                _Pragma("unroll") for (int ks = 0; ks < 4; ++ks) { const u32x2 lo_ = __builtin_bit_cast(u32x2, k0_[ks]), hi_ = __builtin_bit_cast(u32x2, k1_[ks]); u32x4 kk_; kk_.x = lo_.x; kk_.y = lo_.y; kk_.z = hi_.x; kk_.w = hi_.y; \
                    Gt[s4] = MFMA16(__builtin_bit_cast(bf16x8, kk_), Q[ks], Gt[s4]); } } \
            float dsum = 0.f; unsigned pk_[8]; \
            _Pragma("unroll") for (int s4 = 0; s4 < 4; ++s4) { f32x4 wv = (f32x4){0.f, 0.f, 0.f, 0.f}; if (MLSTM) wv = *(const LAS f32x4*)(V_ + SC_GW + (16 * s4 + 4 * kq) * 4); float gm[4]; \
                _Pragma("unroll") for (int r = 0; r < 4; ++r) { const int s = 16 * s4 + 4 * kq + r; const bool keep = dir == 0 ? (s <= t) : (s >= t); gm[r] = keep ? Gt[s4][r] : 0.f; dsum += gm[r] * wv[r]; } \
                pk_[2 * s4] = cvt_pk_bf16(gm[0], gm[1]); pk_[2 * s4 + 1] = cvt_pk_bf16(gm[2], gm[3]); } \
            bf16x8 Pf[2]; { u32x4 t0; t0.x = pk_[0]; t0.y = pk_[1]; t0.z = pk_[2]; t0.w = pk_[3]; Pf[0] = __builtin_bit_cast(bf16x8, t0); u32x4 t1; t1.x = pk_[4]; t1.y = pk_[5]; t1.z = pk_[6]; t1.w = pk_[7]; Pf[1] = __builtin_bit_cast(bf16x8, t1); } \
            f32x4 Ot[4]; \
            _Pragma("unroll") for (int vt = 0; vt < 4; ++vt) { Ot[vt] = (f32x4){0.f, 0.f, 0.f, 0.f}; const int v8 = 4 * vh + vt; \
                _Pragma("unroll") for (int ks = 0; ks < 4; ++ks) Ot[vt] = MFMA16(*(const LAS bf16x8*)(lds + SC_ST + (16 * v8 + j15) * 256 + (((4 * ks + kq) ^ j15) << 4)), Q[ks], Ot[vt]); \
                _Pragma("unroll") for (int ks = 0; ks < 2; ++ks) { const LAS unsigned char* vp_ = B_ + SC_VT + vtL + v8 * 2048 + ks * 1024; const u32x2 lo_ = *(const LAS u32x2*)vp_, hi_ = *(const LAS u32x2*)(vp_ + 512); \
                    u32x4 vv_; vv_.x = lo_.x; vv_.y = lo_.y; vv_.z = hi_.x; vv_.w = hi_.y; Ot[vt] = MFMA16(__builtin_bit_cast(bf16x8, vv_), Pf[ks], Ot[vt]); } \
                asm volatile("" ::: "memory"); } \
            float sc = 1.0f; \
            if (MLSTM) { float nint = 0.f; \
                _Pragma("unroll") for (int ks = 0; ks < 4; ++ks) { const f32x4 n0 = *(const LAS f32x4*)(lds + SC_NS + (32 * ks + 8 * kq) * 4), n1 = *(const LAS f32x4*)(lds + SC_NS + (32 * ks + 8 * kq + 4) * 4); float q[8]; unpack8(__builtin_bit_cast(u32x4, Q[ks]), q); \
                    nint += q[0] * n0[0] + q[1] * n0[1] + q[2] * n0[2] + q[3] * n0[3] + q[4] * n1[0] + q[5] * n1[1] + q[6] * n1[2] + q[7] * n1[3]; } \
                float tot = dsum + nint; tot += __shfl_xor(tot, 16); tot += __shfl_xor(tot, 32); \
                const float g1 = *(const LAS float*)(V_ + SC_G1 + t * 4); sc = g1 / fmaxf(fabsf(g1 * tot), 1.0f); } \
            bf16_t* op_ = HSo + (size_t)(SC_ROW0(cc) + t) * 512 + 64 * vh + 4 * kq; \
            _Pragma("unroll") for (int vt = 0; vt < 4; ++vt) { u32x2 o_; o_.x = cvt_pk_bf16(Ot[vt][0] * sc, Ot[vt][1] * sc); o_.y = cvt_pk_bf16(Ot[vt][2] * sc, Ot[vt][3] * sc); *(u32x2*)(op_ + 16 * vt) = o_; } } \
          \
        _Pragma("unroll") for (int ks = 0; ks < 2; ++ks) { bf16x8 vf_[2]; _Pragma("unroll") for (int vt = 0; vt < 2; ++vt) vf_[vt] = *(const LAS bf16x8*)(B_ + SC_VT + ((2 * vq + vt) * 2 + ks) * 1024 + lane * 16); \
            _Pragma("unroll") for (int dt = 0; dt < 4; ++dt) { const bf16x8 kf_ = *(const LAS bf16x8*)(B_ + SC_KT + ((4 * dh + dt) * 2 + ks) * 1024 + lane * 16); \
                _Pragma("unroll") for (int vt = 0; vt < 2; ++vt) acc[dt][vt] = MFMA16(kf_, vf_[vt], acc[dt][vt]); } \
            if (MLSTM) { const bf16x8 kn_ = *(const LAS bf16x8*)(B_ + SC_KT + ((4 * dh + vq) * 2 + ks) * 1024 + lane * 16); bf16x8 wf_ = *(const LAS bf16x8*)(V_ + SC_WB + (32 * ks + 8 * kq) * 2); \
                if (j15 != 0) wf_ = (bf16x8){0, 0, 0, 0, 0, 0, 0, 0}; accn = MFMA16(kn_, wf_, accn); } } \
        SC_WAITFOR((st) + 1); \
    } while (0)
#pragma unroll 1
    for (int step = 0; step < 36; step += 2) { SC_STEP(Qa, Qb, step); SC_STEP(Qb, Qa, step + 1); }
    asm volatile("s_waitcnt vmcnt(0) lgkmcnt(0)" ::: "memory");
#undef SC_STEP
#undef SC_WAITFOR
#undef SC_LOADQ
#undef SC_DMA
#undef SC_ROW0
#undef SC_CC
}
__device__ __forceinline__ void ph_scan2(const Params& p, LAS unsigned char* lds) {
    for (int item = blockIdx.x; item < 256; item += gridDim.x) {
        const int kind = item >> 7, r = item & 127, b = r >> 3, h = (r >> 1) & 3, dir = r & 1;
        if (kind == 0) scan2_item<true>(p, lds, b, h, dir); else scan2_item<false>(p, lds, b, h, dir);
    }
    __syncthreads();
}

__device__ __forceinline__ void ph_merge(const Params& p) {
    const int tid = otid(), lane = tid & 63, wave = __builtin_amdgcn_readfirstlane(tid >> 6);
    const bf16_t* PL = (const bf16_t*)(p.ws + WS_PL); const bf16_t* HS = (const bf16_t*)(p.ws + WS_HS); bf16_t* AB = (bf16_t*)(p.ws + WS_AB);
    const float* m_norm = p.in[14]; const float* h_norm = p.in[15];
    const int gw = blockIdx.x * 8 + wave, NGW = gridDim.x * 8, c0 = lane * 8;
    u32x4 n0[2], n1[2], ng[2];
#define MG_LOAD(tok_) do { _Pragma("unroll") for (int kind_ = 0; kind_ < 2; ++kind_) { n0[kind_] = __builtin_nontemporal_load((const u32x4*)(HS + ((size_t)(2 * kind_) * NTOK + (tok_)) * 512 + c0)); \
        n1[kind_] = __builtin_nontemporal_load((const u32x4*)(HS + ((size_t)(2 * kind_ + 1) * NTOK + (tok_)) * 512 + c0)); ng[kind_] = *(const u32x4*)(PL + (size_t)(tok_) * PL_W + (kind_ ? PL_HG : PL_MO) + c0); } } while (0)
    if (gw < NTOK) MG_LOAD(gw);
    for (int tok = gw; tok < NTOK; tok += NGW) {
        u32x4 c0r[2], c1r[2], cgr[2];
#pragma unroll
        for (int kind = 0; kind < 2; ++kind) { c0r[kind] = n0[kind]; c1r[kind] = n1[kind]; cgr[kind] = ng[kind]; }
        if (tok + NGW < NTOK) MG_LOAD(tok + NGW);
#pragma unroll
        for (int kind = 0; kind < 2; ++kind) {
            const u32x4 r0 = c0r[kind], r1 = c1r[kind];
            const u32x4 rg = cgr[kind];
            const float* nw = (kind ? h_norm : m_norm) + c0; const f32x4 w0 = *(const f32x4*)nw, w1 = *(const f32x4*)(nw + 4);
            float a[8], b[8], g[8]; unpack8(r0, a); unpack8(r1, b); unpack8(rg, g);
            float ss = 0.f;
#pragma unroll
            for (int i = 0; i < 8; ++i) { a[i] += b[i]; ss += a[i] * a[i]; }
            ss += __shfl_xor(ss, 1); ss += __shfl_xor(ss, 2); ss += __shfl_xor(ss, 4); ss += __shfl_xor(ss, 8);
            const float rstd = rsqrtf(ss * (1.0f / 128.0f) + EPS);
#pragma unroll
            for (int i = 0; i < 8; ++i) a[i] = a[i] * rstd * (i < 4 ? w0[i] : w1[i - 4]) * g[i];
            *(u32x4*)(AB + ((size_t)kind * NTOK + tok) * 512 + c0) = pack8(a);
        }
    }
}

typedef float f32x16 __attribute__((ext_vector_type(16)));
__device__ __forceinline__ void ph_post(const Params& p, LAS unsigned char* lds) {
    const int tid = otid(), lane = tid & 63, wave = __builtin_amdgcn_readfirstlane(tid >> 6);
    constexpr int TP = 1025;
    LAS float* tile = (LAS float*)lds;
    LAS float* vec = (LAS float*)(lds + 131328);
    LAS int* hist = (LAS int*)(lds + 131328 + 12288);
    const float* w_router = p.in[19]; const float* b_router = p.in[20];
    float breg[64];
#pragma unroll
    for (int s = 0; s < 64; ++s) breg[s] = w_router[(size_t)(128 * wave + 2 * s + (lane >> 5)) * 32 + (lane & 31)];
    const float* x = p.in[0]; const float* wpost = p.in[7]; const float* wfpre = p.in[8];
    const float* mod = (const float*)(p.ws + WS_MOD); const bf16_t* YL = (const bf16_t*)(p.ws + WS_YL); unsigned char* HL2 = p.ws + WS_HL;
    int* top_e = (int*)(p.ws + WS_TOPE); float* top_w = (float*)(p.ws + WS_TOPW); int* cntWG = (int*)(p.ws + WS_CNT);
    u32x2 yrg[4][4]; f32x4 xrg[4][4];
#define PO_LOADG(tok0_) do { _Pragma("unroll") for (int tt_ = 0; tt_ < 4; ++tt_) { const u32x2* yrow_ = (const u32x2*)(YL + (size_t)((tok0_) + tt_) * D); const f32x4* xrow_ = (const f32x4*)(x + (size_t)((tok0_) + tt_) * D); \
        _Pragma("unroll") for (int j_ = 0; j_ < 4; ++j_) { yrg[tt_][j_] = __builtin_nontemporal_load(yrow_ + lane + 64 * j_); xrg[tt_][j_] = __builtin_nontemporal_load(xrow_ + lane + 64 * j_); } } } while (0)
    if ((int)blockIdx.x < 256) PO_LOADG(blockIdx.x * 128 + wave * 4);
    for (int blk = blockIdx.x; blk < 256; blk += gridDim.x) {
        const float* mb = mod + (blk >> 4) * 6144;
        for (int i = tid; i < 1024; i += 512) { vec[i] = mb[2048 + i] * wpost[i]; vec[1024 + i] = wfpre[i] * (1.0f + mb[4096 + i]); vec[2048 + i] = mb[3072 + i]; }
        if (tid < 32) hist[tid] = 0;
        __syncthreads();
#pragma unroll 1
        for (int g = 0; g < 4; ++g) {
#pragma unroll
            for (int tt = 0; tt < 4; ++tt) {
                const int tl = wave * 4 + tt, tok = blk * 128 + g * 32 + tl;
                u32x2* orow = (u32x2*)(p.ws + WS_X1B) + (size_t)tok * (D / 4);
                f32x4 yv[4], xv[4]; float ss = 0.f;
#pragma unroll
                for (int j = 0; j < 4; ++j) { const u32x2 yr = yrg[tt][j]; yv[j] = (f32x4){bf_lo(yr.x), bf_hi(yr.x), bf_lo(yr.y), bf_hi(yr.y)}; xv[j] = xrg[tt][j];
                    ss += yv[j].x * yv[j].x + yv[j].y * yv[j].y + yv[j].z * yv[j].z + yv[j].w * yv[j].w; }
                ss = wave_sum(ss); const float rstd = rsqrtf(ss * (1.0f / D) + EPS);
                float ss2 = 0.f;
#pragma unroll
                for (int j = 0; j < 4; ++j) { const f32x4 gw = *(const LAS f32x4*)(vec + 4 * lane + 256 * j);
#pragma unroll
                    for (int i = 0; i < 4; ++i) { xv[j][i] = xv[j][i] + gw[i] * (yv[j][i] * rstd); ss2 += xv[j][i] * xv[j][i]; }
                    { u32x2 xo; xo.x = cvt_pk_bf16(xv[j][0], xv[j][1]); xo.y = cvt_pk_bf16(xv[j][2], xv[j][3]); __builtin_nontemporal_store(xo, orow + lane + 64 * j); } }
                ss2 = wave_sum(ss2); const float rstd2 = rsqrtf(ss2 * (1.0f / D) + EPS);
#pragma unroll
                for (int j = 0; j < 4; ++j) { const f32x4 a2 = *(const LAS f32x4*)(vec + 1024 + 4 * lane + 256 * j), s2 = *(const LAS f32x4*)(vec + 2048 + 4 * lane + 256 * j);
                    LAS float* trow = tile + tl * TP + 4 * lane + 256 * j;
#pragma unroll
                    for (int i = 0; i < 4; ++i) { yv[j][i] = xv[j][i] * rstd2 * a2[i] + s2[i]; trow[i] = yv[j][i]; }
                    *(unsigned*)(HL2 + (size_t)tok * D + 4 * lane + 256 * j) = pk_fp8x4(yv[j][0], yv[j][1], yv[j][2], yv[j][3]); }
            }
            __syncthreads();
            { const int ng = g + 1, nblk = ng < 4 ? blk : blk + (int)gridDim.x; if (nblk < 256) PO_LOADG(nblk * 128 + (ng & 3) * 32 + wave * 4); }
            f32x16 acc;
#pragma unroll
            for (int r = 0; r < 16; ++r) acc[r] = 0.f;
            { const LAS float* ap = tile + (lane & 31) * TP + 128 * wave + (lane >> 5);
#pragma unroll
                for (int s = 0; s < 64; ++s) acc = __builtin_amdgcn_mfma_f32_32x32x2f32(ap[2 * s], breg[s], acc, 0, 0, 0); }
            __syncthreads();
#pragma unroll
            for (int r = 0; r < 16; ++r) tile[(wave * 32 + (r & 3) + 8 * (r >> 2) + 4 * (lane >> 5)) * 32 + (lane & 31)] = acc[r];
            __syncthreads();
#pragma unroll
            for (int rr = 0; rr < 2; ++rr) { const int o = tid + 512 * rr; float sa = b_router[o & 31];
#pragma unroll
                for (int w8 = 0; w8 < 8; ++w8) sa += tile[w8 * 1024 + o];
                tile[8192 + (o >> 5) * 33 + (o & 31)] = sa; }
            __syncthreads();
#pragma unroll 1
            for (int tt = 0; tt < 4; ++tt) {
                const int tl = wave * 4 + tt, tok = blk * 128 + g * 32 + tl;
                const int ci = lane >> 1; float cv = tile[8192 + tl * 33 + ci];
                float tv[4]; int ti[4];
#pragma unroll
                for (int k = 0; k < 4; ++k) { float bv = cv; int bi = ci;
#pragma unroll
                    for (int o = 1; o < 64; o <<= 1) { const float ov = __shfl_xor(bv, o); const int oi = __shfl_xor(bi, o); const bool take = (ov > bv) || (ov == bv && oi < bi); bv = take ? ov : bv; bi = take ? oi : bi; }
                    tv[k] = bv; ti[k] = bi; cv = (ci == bi) ? -3.0e38f : cv; }
                const float e1 = __expf(tv[1] - tv[0]), e2 = __expf(tv[2] - tv[0]), e3 = __expf(tv[3] - tv[0]); const float inv = 1.0f / (1.0f + e1 + e2 + e3);
                if (lane == 0) { *(int4*)(top_e + (size_t)tok * 4) = make_int4(ti[0], ti[1], ti[2], ti[3]); *(f32x4*)(top_w + (size_t)tok * 4) = (f32x4){inv, e1 * inv, e2 * inv, e3 * inv};
#pragma unroll
                    for (int k = 0; k < 4; ++k) __hip_atomic_fetch_add(&hist[ti[k]], 1, __ATOMIC_RELAXED, __HIP_MEMORY_SCOPE_WORKGROUP); }
            }
            __syncthreads();
        }
        if (tid < 32) cntWG[blk * 32 + tid] = hist[tid];
        __syncthreads();
    }
}

__device__ __forceinline__ void ph_scatter(const Params& p, LAS unsigned char* lds) {
    const int tid = otid(), lane = tid & 63, wave = __builtin_amdgcn_readfirstlane(tid >> 6);
    LAS int* sm = (LAS int*)lds;
    const int* cntWG = (const int*)(p.ws + WS_CNT); const int* top_e = (const int*)(p.ws + WS_TOPE); const float* top_w = (const float*)(p.ws + WS_TOPW);
    int* dest_arr = (int*)(p.ws + WS_DEST); float* pw = (float*)(p.ws + WS_PW); int* tab = (int*)(p.ws + WS_TAB);
    int* ptok = (int*)(p.ws + WS_PTOK);
    for (int blk = blockIdx.x; blk < 256; blk += gridDim.x) {
        if (tid < 32) { int tot = 0, bef = 0; for (int w = 0; w < 256; ++w) { const int c = cntWG[w * 32 + tid]; tot += c; bef += (w < blk) ? c : 0; } sm[tid] = tot; sm[32 + tid] = bef; }
        __syncthreads();
        if (tid == 0) { int run = 0; for (int e = 0; e < 32; ++e) { sm[96 + e] = run; sm[64 + e] = run + sm[32 + e]; run += (sm[e] + 255) & ~255; } if (blk == 0) tab[0] = run >> 8; }
        __syncthreads();
        if (blk == 0 && tid < 32) { const int b0 = sm[96 + tid] >> 8, nb = (sm[tid] + 255) >> 8; for (int i = 0; i < nb; ++i) tab[1 + b0 + i] = tid;
            for (int i = sm[tid]; i < nb * 256; ++i) ptok[sm[96 + tid] + i] = 0; }
        const int tok = blk * 128 + (tid >> 2), k = tid & 3;
        const int e = top_e[(size_t)tok * 4 + k];
        int rank = 0;
        for (int ee = 0; ee < 32; ++ee) { const unsigned long long mask = __ballot(e == ee); if (e == ee) rank = __popcll(mask & ((1ull << lane) - 1ull)); if (lane == 0) sm[128 + wave * 32 + ee] = __popcll(mask); }
        __syncthreads();
        int off = 0; for (int w = 0; w < wave; ++w) off += sm[128 + w * 32 + e];
        const int dest = sm[64 + e] + off + rank;
        dest_arr[(size_t)tok * 4 + k] = dest; pw[dest] = top_w[(size_t)tok * 4 + k]; ptok[dest] = tok;
        __syncthreads();
    }
}

__device__ __forceinline__ void ph_combine(const Params& p) {
    const int tid = otid(), lane = tid & 63, wave = __builtin_amdgcn_readfirstlane(tid >> 6);
    const unsigned char* YB = p.ws + WS_YB; const int* dest_arr = (const int*)(p.ws + WS_DEST); const float* mod = (const float*)(p.ws + WS_MOD); const float* wpost2 = p.in[9];
    const int gw = blockIdx.x * 8 + wave, NGW = gridDim.x * 8;
    for (int tok = gw; tok < NTOK; tok += NGW) {
        const int b = tok >> 11; const float* g2 = mod + b * 6144 + 5120;
        const int4 dd = *(const int4*)(dest_arr + (size_t)tok * 4); const int ds[4] = {dd.x, dd.y, dd.z, dd.w};
        float y[2][8];
#pragma unroll
        for (int s = 0; s < 2; ++s)
#pragma unroll
            for (int i = 0; i < 8; ++i) y[s][i] = 0.f;
#pragma unroll
        for (int k = 0; k < 4; ++k)
#pragma unroll
            for (int s = 0; s < 2; ++s) { const u32x2 r = __builtin_nontemporal_load((const u32x2*)(YB + (size_t)ds[k] * D + s * 512 + lane * 8));
                const f32x2 f0 = __builtin_amdgcn_cvt_pk_f32_fp8((int)r.x, false), f1 = __builtin_amdgcn_cvt_pk_f32_fp8((int)r.x, true), f2 = __builtin_amdgcn_cvt_pk_f32_fp8((int)r.y, false), f3 = __builtin_amdgcn_cvt_pk_f32_fp8((int)r.y, true);
                y[s][0] += f0.x; y[s][1] += f0.y; y[s][2] += f1.x; y[s][3] += f1.y; y[s][4] += f2.x; y[s][5] += f2.y; y[s][6] += f3.x; y[s][7] += f3.y; }
        float ss = 0.f;
#pragma unroll
        for (int s = 0; s < 2; ++s)
#pragma unroll
            for (int i = 0; i < 8; ++i) ss += y[s][i] * y[s][i];
        ss = wave_sum(ss); const float rstd = rsqrtf(ss * (1.0f / D) + EPS * (F8_YSCALE * F8_YSCALE));
#pragma unroll
        for (int s = 0; s < 2; ++s)
#pragma unroll
            for (int q = 0; q < 2; ++q) { const int ci = s * 512 + lane * 8 + 4 * q; float* op = p.out + (size_t)tok * D + ci;
                const u32x2 xr = __builtin_nontemporal_load((const u32x2*)((const bf16_t*)(p.ws + WS_X1B) + (size_t)tok * D + ci)); const f32x4 x1 = (f32x4){bf_lo(xr.x), bf_hi(xr.x), bf_lo(xr.y), bf_hi(xr.y)};
                const f32x4 gv = *(const f32x4*)(g2 + ci), wv = *(const f32x4*)(wpost2 + ci); f32x4 o;
#pragma unroll
                for (int i = 0; i < 4; ++i) o[i] = x1[i] + gv[i] * (y[s][4 * q + i] * rstd * wv[i]);
                __builtin_nontemporal_store(o, (f32x4*)op); }
    }
}

#define XB_TMO      128
#define XB_XCNT(j)  (256  + 64 * (j))
#define XB_XSUB(j)  (1280 + 64 * (j))
#define XB_XGEN(j)  (2304 + 64 * (j))
#define XB_TOP      3328
#define XB_TOPGEN   3392
#define XCD_BAR_WORDS 3456
#define XB_SPIN_CAP (1u << 18)
__device__ __forceinline__ unsigned xb_ld(unsigned* p)              { return __hip_atomic_load(p, __ATOMIC_RELAXED, __HIP_MEMORY_SCOPE_AGENT); }
__device__ __forceinline__ unsigned xb_add(unsigned* p, unsigned v) { return __hip_atomic_fetch_add(p, v, __ATOMIC_RELAXED, __HIP_MEMORY_SCOPE_AGENT); }
__device__ __forceinline__ unsigned xb_xcc_id() { return (unsigned)__builtin_amdgcn_s_getreg((3 << 11) | 20) & 0xFu; }
#define XB_SPIN(cond, bar) do { unsigned _sp = 0; while (cond) { __builtin_amdgcn_s_sleep(1); \
    if ((++_sp & 255u) == 0u) { if (xb_ld(&(bar)[XB_TMO])) break; if (_sp > XB_SPIN_CAP) { atomicAdd(&(bar)[XB_TMO], 1u); break; } } } } while (0)
struct XcdBarrier { unsigned* bar; unsigned x; volatile LAS unsigned* st; };
__device__ __forceinline__ XcdBarrier xcd_barrier_post(unsigned* bar, volatile LAS unsigned* st) {
    XcdBarrier b; b.bar = bar; b.x = xb_xcc_id(); b.st = st;
    if (threadIdx.x == 0) (void)xb_add(&bar[XB_XCNT(b.x)], 1u);
    return b;
}
__device__ __forceinline__ void xcd_barrier_complete(unsigned* bar, unsigned x, unsigned& nloc, unsigned& nx) {
    const unsigned G = gridDim.x * gridDim.y * gridDim.z;
    unsigned sum, cnt, mine, sp = 0u;
    for (;;) {
        sum = 0u; cnt = 0u; mine = 0u;
#pragma unroll
        for (unsigned j = 0; j < 16; ++j) { const unsigned c = xb_ld(&bar[XB_XCNT(j)]); sum += c; cnt += (c > 0u) ? 1u : 0u; mine = (j == x) ? c : mine; }
        if (sum == G) break;
        __builtin_amdgcn_s_sleep(1);
        if ((++sp & 255u) == 0u) { if (xb_ld(&bar[XB_TMO])) break; if (sp > XB_SPIN_CAP) { atomicAdd(&bar[XB_TMO], 1u); break; } }
    }
    nloc = mine > 0u ? mine : 1u; nx = cnt > 0u ? cnt : 1u;
}
__device__ __forceinline__ void xcd_barrier(const XcdBarrier& b) {
    asm volatile("s_waitcnt vmcnt(0)" ::: "memory");
    __syncthreads();
    if (threadIdx.x == 0) {
        unsigned* bar = b.bar;
        __builtin_amdgcn_s_waitcnt(0);
        unsigned nloc = b.st[0], nx = b.st[1];
        if (nloc == 0u) { xcd_barrier_complete(bar, b.x, nloc, nx); b.st[0] = nloc; b.st[1] = nx; }
        const unsigned old = xb_add(&bar[XB_XSUB(b.x)], 1u);
        const unsigned gen = old / nloc;
        if (old + 1u == (gen + 1u) * nloc) {
            __builtin_amdgcn_fence(__ATOMIC_RELEASE, "agent");
            asm volatile("s_waitcnt vmcnt(0)" ::: "memory");
            const unsigned og = xb_add(&bar[XB_TOP], 1u);
            const unsigned tg = og / nx;
            if (og + 1u == (tg + 1u) * nx) xb_add(&bar[XB_TOPGEN], 1u);
            else XB_SPIN(xb_ld(&bar[XB_TOPGEN]) == tg, bar);
            __builtin_amdgcn_fence(__ATOMIC_ACQUIRE, "agent");
            xb_add(&bar[XB_XGEN(b.x)], 1u);
            asm volatile("s_waitcnt vmcnt(0)" ::: "memory");
        } else {
            XB_SPIN(xb_ld(&bar[XB_XGEN(b.x)]) == gen, bar);
            __builtin_amdgcn_fence(__ATOMIC_ACQUIRE, "agent");
            asm volatile("s_waitcnt vmcnt(0)" ::: "memory");
        }
    }
    __syncthreads();
}

typedef const __attribute__((address_space(4))) Params* KParams;
__device__ __forceinline__ Params load_params() {
    Params q{};
#if defined(__HIP_DEVICE_COMPILE__)
    KParams kp = (KParams)__builtin_amdgcn_kernarg_segment_ptr(); asm volatile("" : "+s"(kp));
#pragma unroll
    for (int i = 0; i < 25; ++i) q.in[i] = kp->in[i];
    q.out = kp->out; q.ws = kp->ws; q.ph_lo = kp->ph_lo; q.ph_hi = kp->ph_hi;
#endif
    return q;
}
__global__ void __launch_bounds__(512, 2) mega_fwd(Params pk) {
    extern __shared__ __attribute__((aligned(16))) unsigned char lds_raw[];
    LAS unsigned char* lds = (LAS unsigned char*)lds_raw;
    cg::grid_group grid = cg::this_grid();
    const int G = gridDim.x, c = blockIdx.x;
#ifndef PHASE_MASK
#define PHASE_MASK 0x3fff
#endif
#define IN(k) (((PHASE_MASK >> (k)) & 1) && pk.ph_lo <= (k) && (k) < pk.ph_hi)
    volatile LAS unsigned* bst = (volatile LAS unsigned*)(lds + LDS_BYTES - 16);
    if (threadIdx.x < 2) bst[threadIdx.x] = 0u;
    __syncthreads();
    const XcdBarrier xbar = xcd_barrier_post((unsigned*)(pk.ws + WS_BAR), bst);
#define SEAM(k) do { if ((k) + 1 < pk.ph_hi) { if ((k) == 0) grid.sync(); else xcd_barrier(xbar); } } while (0)
#ifndef PROBE_PHASE
#define PROBE_PHASE -1
#define PROBE_REPS 1
#endif
#define NREP(k) ((k) == PROBE_PHASE ? PROBE_REPS : 1)
    for (int rep_ = 0; rep_ < NREP(0); ++rep_) if (IN(0)) { const Params p = load_params(); ph_setup(p, lds); SEAM(0); }
    for (int rep_ = 0; rep_ < NREP(1); ++rep_) if (IN(1)) { const Params p = load_params(); ph_hl(p, lds); SEAM(1); }
    for (int rep_ = 0; rep_ < NREP(2); ++rep_) if (IN(2)) { const Params p = load_params(); pg8::Gemm g{(const bf16_t*)(p.ws + WS_HL), (const bf16_t*)(p.ws + WS_WIN), D}; pg8::OrderP S{G, c};
        pg8::EpiP E{(bf16_t*)(p.ws + WS_PD), (bf16_t*)(p.ws + WS_PL), p.in[11], p.in[13]}; pg8::gemm_phase(lds, g, S, E); SEAM(2); }
    for (int rep_ = 0; rep_ < NREP(3); ++rep_) if (IN(3)) { const Params p = load_params(); ph_prep(p, lds); SEAM(3); }
    for (int rep_ = 0; rep_ < NREP(4); ++rep_) if (IN(4)) { const Params p = load_params(); ph_scan2(p, lds); SEAM(4); }
    for (int rep_ = 0; rep_ < NREP(5); ++rep_) if (IN(5)) { const Params p = load_params(); ph_merge(p); SEAM(5); }
    for (int rep_ = 0; rep_ < NREP(6); ++rep_) if (IN(6)) { const Params p = load_params(); pg8::Gemm g{(const bf16_t*)(p.ws + WS_AB), (const bf16_t*)(p.ws + WS_WPAB), 512}; pg8::OrderY S{G, c};
        pg8::EpiY E{(bf16_t*)(p.ws + WS_Y), (const bf16_t*)(p.ws + WS_PL)}; pg8::gemm_phase(lds, g, S, E); SEAM(6); }
    for (int rep_ = 0; rep_ < NREP(8); ++rep_) if (IN(8)) { const Params p = load_params(); pg8::Gemm g{(const bf16_t*)(p.ws + WS_Y), (const bf16_t*)(p.ws + WS_WOUT), D}; pg8::StaticOrder S{NTOK / 256, 4, G, c};
        pg8::EpiBf E{(bf16_t*)(p.ws + WS_YL), D}; pg8::gemm_phase(lds, g, S, E); SEAM(8); }
    for (int rep_ = 0; rep_ < NREP(9); ++rep_) if (IN(9)) { const Params p = load_params(); ph_post(p, lds); SEAM(9); }
    for (int rep_ = 0; rep_ < NREP(10); ++rep_) if (IN(10)) { const Params p = load_params(); ph_scatter(p, lds); __syncthreads(); ph_wexp(p, lds); SEAM(10); }
    for (int rep_ = 0; rep_ < NREP(11); ++rep_) if (IN(11)) { const Params p = load_params();
        LAS int* tab = (LAS int*)(lds + LDS_STAGE); const int* gtab = (const int*)(p.ws + WS_TAB);
        for (int i = otid(); i < 1 + MAXBLK; i += 512) tab[i] = gtab[i];
        __syncthreads();
        pg8::Gemm g{(const bf16_t*)(p.ws + WS_HL), (const bf16_t*)(p.ws + WS_WGU), D / 2}; pg8::OrderMoe<true> S{G, c, 8, tab, (const int*)(p.ws + WS_PTOK)};
        pg8::EpiAct E{p.ws + WS_ACT, p.in[22]}; pg8::gemm_phase(lds, g, S, E); SEAM(11); }
    for (int rep_ = 0; rep_ < NREP(12); ++rep_) if (IN(12)) { const Params p = load_params();
        LAS int* tab = (LAS int*)(lds + LDS_STAGE); const int* gtab = (const int*)(p.ws + WS_TAB);
        for (int i = otid(); i < 1 + MAXBLK; i += 512) tab[i] = gtab[i];
        __syncthreads();
        pg8::Gemm g{(const bf16_t*)(p.ws + WS_ACT), (const bf16_t*)(p.ws + WS_WDN), D / 2}; pg8::OrderMoe<false> S{G, c, 4, tab, nullptr};
        pg8::EpiDown E{p.ws + WS_YB, p.in[24], (const float*)(p.ws + WS_PW)}; pg8::gemm_phase(lds, g, S, E); SEAM(12); }
    for (int rep_ = 0; rep_ < NREP(13); ++rep_) if (IN(13)) { const Params p = load_params(); ph_combine(p); }
#undef IN
#undef SEAM
}

#ifndef N_LAUNCH_MODE
#define N_LAUNCH_MODE 1
#endif

extern "C" void kernel_launch(void* const* d_in, const int* in_sizes, int n_in, void* d_out, int out_size, void* d_ws, size_t ws_size, hipStream_t stream) {
    static int grid_blocks = 0;
    if (grid_blocks == 0) {
        if (n_in != 25 || ws_size < WS_END) { fprintf(stderr, "kernel_launch: unexpected n_in %d or ws_size %zu (< %zu)\n", n_in, ws_size, (size_t)WS_END); grid_blocks = -1; return; }
        int dev = 0, cus = 0, per_cu = 0;
        hipGetDevice(&dev);
        hipDeviceGetAttribute(&cus, hipDeviceAttributeMultiprocessorCount, dev);
        hipFuncSetAttribute((const void*)mega_fwd, hipFuncAttributeMaxDynamicSharedMemorySize, LDS_BYTES);
        hipOccupancyMaxActiveBlocksPerMultiprocessor(&per_cu, (const void*)mega_fwd, 512, LDS_BYTES);
        if (per_cu < 1) { fprintf(stderr, "kernel_launch: occupancy query says %d blocks/CU\n", per_cu); per_cu = 1; }
        if (per_cu > 1) per_cu = 1;
        grid_blocks = cus * per_cu;
    }
    if (grid_blocks < 0) return;
    if (hipMemsetAsync((char*)d_ws + WS_BAR, 0, 16384, stream) != hipSuccess) { fprintf(stderr, "kernel_launch: memset of the barrier words failed\n"); return; }
    Params p{};
    for (int i = 0; i < 25; ++i) p.in[i] = (const float*)d_in[i];
    p.out = (float*)d_out; p.ws = (unsigned char*)d_ws;
#if N_LAUNCH_MODE == 1
    p.ph_lo = 0; p.ph_hi = NPHASE;
    { void* args[] = {&p}; hipError_t e = hipLaunchCooperativeKernel((const void*)mega_fwd, dim3(grid_blocks), dim3(512), args, LDS_BYTES, stream);
      if (e != hipSuccess) fprintf(stderr, "cooperative launch failed: %s (grid %d)\n", hipGetErrorString(e), grid_blocks); }
#else
    for (int ph = 0; ph < NPHASE; ++ph) {
        p.ph_lo = ph; p.ph_hi = ph + 1;
        void* args[] = {&p}; hipError_t e = hipLaunchCooperativeKernel((const void*)mega_fwd, dim3(grid_blocks), dim3(512), args, LDS_BYTES, stream);
        if (e != hipSuccess) { fprintf(stderr, "cooperative launch (phase %d) failed: %s (grid %d)\n", ph, hipGetErrorString(e), grid_blocks); break; }
    }
#endif
}
```
